# Optimizing an MI355X kernel written in HIP

```python
import math
import numpy as np
import jax
import jax.numpy as jnp
from jax import lax

D_MODEL = 1024
BATCH = 8
SEQ = 2048
DEPTH = 4

CTX_LEN = 256
GRID_W = 64
N_MIXERS = 3
EXPAND = 2
D_INNER = EXPAND * D_MODEL
EPS = 1e-6
DIFF_DH = 64
DIFF_VDH = 2 * DIFF_DH
DIFF_HEADS = D_INNER // DIFF_VDH
ATTN_QBLOCK = 128
ROPE_THETA = 10000.0
NA_DH = 64
NA_HEADS = D_INNER // NA_DH
NA_WIN_H = 8
NA_WIN_W = 16
NA_QCB = NA_WIN_W
NA_BAND = 2 * NA_WIN_W
NA_NCB = GRID_W // NA_QCB
MLSTM_HEADS = 4
MLSTM_DH = D_INNER // MLSTM_HEADS
MLSTM_CONV = 4
MLSTM_CONV_PAD = (2, 1)
QKV_BLOCK = 4
QKV_NBLK = D_INNER // QKV_BLOCK
MLSTM_CHUNK = 64

kernel_name = "hybrid_diffattn_natten_mlstm_prefix_dit"

F32 = jnp.float32


def rms_norm(x, g):
    x32 = x.astype(F32)
    y = x32 * lax.rsqrt(jnp.mean(x32 * x32, axis=-1, keepdims=True) + EPS)
    return (y * g.astype(F32)).astype(x.dtype)


def adaln(cvec, w, b):
    e = jax.nn.silu(cvec) @ w + b
    return jnp.split(e, 3, axis=-1)


def axial_rope(n_tok, dtype):
    t = jnp.arange(n_tok)
    row = (t // GRID_W).astype(F32)
    col = (t % GRID_W).astype(F32)
    n_freq = DIFF_DH // 4
    inv = ROPE_THETA ** (-jnp.arange(n_freq, dtype=F32) / n_freq)
    ar = row[:, None] * inv
    ac = col[:, None] * inv
    ang = jnp.concatenate([ar, ar, ac, ac], axis=-1)[:, None, :]
    return jnp.cos(ang).astype(dtype), jnp.sin(ang).astype(dtype)


def apply_axial_rope(x, cos, sin):
    xs = x.reshape(*x.shape[:-1], 2, 2, DIFF_DH // 4)
    rot = jnp.concatenate([-xs[..., 1:, :], xs[..., :1, :]], axis=-2).reshape(x.shape)
    return x * cos + rot * sin


def diff_softmax_pair(q, k, v, lam, scale):
    s = jnp.einsum('bqnd,bknd->bnqk', q, k).astype(F32) * scale
    p = jax.nn.softmax(s, axis=-1)
    bsz, n2, nq, nk = p.shape
    p = p.reshape(bsz, n2 // 2, 2, nq, nk)
    w = p[:, :, 0] - lam * p[:, :, 1]
    return jnp.einsum('bhqk,bkhe->bqhe', w.astype(v.dtype), v)


def diff_attention_mixer(u_lat, u_ctx, w_in, w_out, qn_g, kn_g, lam_vecs, subln_g, layer_idx, need_ctx):
    bsz, n_lat, _ = u_lat.shape
    n_ctx = u_ctx.shape[1]

    def project(u, n):
        q, k, v, z = jnp.split(u @ w_in, 4, axis=-1)
        q = rms_norm(q.reshape(bsz, n, 2 * DIFF_HEADS, DIFF_DH), qn_g)
        k = rms_norm(k.reshape(bsz, n, 2 * DIFF_HEADS, DIFF_DH), kn_g)
        v = v.reshape(bsz, n, DIFF_HEADS, DIFF_VDH)
        return q, k, v, z

    q_l, k_l, v_l, z_l = project(u_lat, n_lat)
    q_c, k_c, v_c, z_c = project(u_ctx, n_ctx)
    cos, sin = axial_rope(n_lat, q_l.dtype)
    q_l = apply_axial_rope(q_l, cos, sin)
    k_l = apply_axial_rope(k_l, cos, sin)
    k_all = jnp.concatenate([k_l, k_c], axis=1)
    v_all = jnp.concatenate([v_l, v_c], axis=1)

    lam_init = 0.8 - 0.6 * math.exp(-0.3 * layer_idx)
    lv = lam_vecs.astype(F32)
    lam = jnp.exp(jnp.sum(lv[0] * lv[1])) - jnp.exp(jnp.sum(lv[2] * lv[3])) + lam_init
    scale = DIFF_DH ** -0.5

    n_blocks = n_lat // ATTN_QBLOCK
    q_blocks = jnp.moveaxis(q_l.reshape(bsz, n_blocks, ATTN_QBLOCK, 2 * DIFF_HEADS, DIFF_DH), 1, 0)
    o_l = lax.map(lambda qb: diff_softmax_pair(qb, k_all, v_all, lam, scale), q_blocks)
    o_l = jnp.moveaxis(o_l, 0, 1).reshape(bsz, n_lat, DIFF_HEADS, DIFF_VDH)

    def finish(o, z, n):
        o = rms_norm(o, subln_g) * (1.0 - lam_init)
        return (o.reshape(bsz, n, D_INNER) * jax.nn.silu(z)) @ w_out

    out_l = finish(o_l, z_l, n_lat)
    out_c = finish(diff_softmax_pair(q_c, k_c, v_c, lam, scale), z_c, n_ctx) if need_ctx else None
    return out_l, out_c


def neighbourhood_mixer(u_lat, u_ctx, w_in, w_out, qn_g, kn_g, rpb, need_ctx):
    bsz, n_lat, _ = u_lat.shape
    n_ctx = u_ctx.shape[1]
    rows = n_lat // GRID_W
    kh = min(NA_WIN_H, rows)
    scale = NA_DH ** -0.5

    def project(u, n):
        q, k, v, z = jnp.split(u @ w_in, 4, axis=-1)
        q = rms_norm(q.reshape(bsz, n, NA_HEADS, NA_DH), qn_g)
        k = rms_norm(k.reshape(bsz, n, NA_HEADS, NA_DH), kn_g)
        v = v.reshape(bsz, n, NA_HEADS, NA_DH)
        return q, k, v, z

    q_l, k_l, v_l, z_l = project(u_lat, n_lat)
    q_c, k_c, v_c, z_c = project(u_ctx, n_ctx)
    dt = v_l.dtype

    cols = np.arange(GRID_W)
    win_start = np.clip(cols - NA_WIN_W // 2, 0, GRID_W - NA_WIN_W)
    band_start = np.clip(np.arange(NA_NCB) * NA_QCB - NA_WIN_W // 2, 0, GRID_W - NA_BAND)
    band_cols = band_start[:, None] + np.arange(NA_BAND)
    qcols = np.arange(NA_NCB)[:, None] * NA_QCB + np.arange(NA_QCB)
    kc = band_cols[:, None, :]
    qc = qcols[:, :, None]
    valid = jnp.asarray((kc >= win_start[qc]) & (kc < win_start[qc] + NA_WIN_W))
    col_bias_idx = np.clip(kc - qc + NA_WIN_W - 1, 0, 2 * NA_WIN_W - 2)
    row_start = jnp.asarray(np.clip(np.arange(rows) - kh // 2, 0, rows - kh).astype(np.int32))

    k_grid = k_l.reshape(bsz, rows, GRID_W, NA_HEADS, NA_DH)
    v_grid = v_l.reshape(bsz, rows, GRID_W, NA_HEADS, NA_DH)
    q_rows = jnp.moveaxis(q_l.reshape(bsz, rows, NA_NCB, NA_QCB, NA_HEADS, NA_DH), 1, 0)
    n_win = kh * NA_BAND

    def row_step(args):
        q_r, r, rs = args
        kr = lax.dynamic_slice_in_dim(k_grid, rs, kh, axis=1)
        vr = lax.dynamic_slice_in_dim(v_grid, rs, kh, axis=1)
        k_band = kr[:, :, band_cols]
        v_band = vr[:, :, band_cols]
        s = jnp.einsum('bnqhd,binxhd->bhnqix', q_r, k_band).astype(F32) * scale
        row_idx = rs - r + jnp.arange(kh) + (NA_WIN_H - 1)
        bias = rpb[:, row_idx][:, :, col_bias_idx]
        bias = jnp.transpose(bias, (0, 2, 3, 1, 4)).astype(F32)
        s = jnp.where(valid[:, :, None, :], s + bias, -jnp.inf)
        s = s.reshape(bsz, NA_HEADS, NA_NCB, NA_QCB, n_win)
        s_ctx = jnp.einsum('bnqhd,bkhd->bhnqk', q_r, k_c).astype(F32) * scale
        p = jax.nn.softmax(jnp.concatenate([s, s_ctx], axis=-1), axis=-1)
        p_band = p[..., :n_win].reshape(bsz, NA_HEADS, NA_NCB, NA_QCB, kh, NA_BAND).astype(dt)
        p_ctx = p[..., n_win:].astype(dt)
        return (jnp.einsum('bhnqix,binxhd->bnqhd', p_band, v_band)
                + jnp.einsum('bhnqk,bkhd->bnqhd', p_ctx, v_c))

    o_l = lax.map(row_step, (q_rows, jnp.arange(rows, dtype=jnp.int32), row_start))
    o_l = jnp.moveaxis(o_l, 0, 1).reshape(bsz, n_lat, D_INNER)
    out_l = (o_l * jax.nn.silu(z_l)) @ w_out
    out_c = None
    if need_ctx:
        s = jnp.einsum('bqhd,bkhd->bhqk', q_c, k_c).astype(F32) * scale
        p = jax.nn.softmax(s, axis=-1).astype(dt)
        o_c = jnp.einsum('bhqk,bkhd->bqhd', p, v_c).reshape(bsz, n_ctx, D_INNER)
        out_c = (o_c * jax.nn.silu(z_c)) @ w_out
    return out_l, out_c


def mlstm_chunk_scan(q, k, v, i_pre, log_f, state):
    bsz, nh, n_tok, dh = q.shape
    L = MLSTM_CHUNK
    nc = n_tok // L

    def to_chunks(t):
        return jnp.moveaxis(t.reshape(bsz, nh, nc, L, *t.shape[3:]), 2, 0)

    causal = jnp.tril(jnp.ones((L, L), dtype=bool))

    def step(carry, xs):
        C, n, m = carry
        qc, kc, vc, ic, fc = xs
        b = jnp.cumsum(fc, axis=-1)
        dmat = jnp.where(causal, b[..., :, None] - b[..., None, :] + ic[..., None, :], -jnp.inf)
        g = b + m[..., None]
        m_t = jnp.maximum(g, jnp.max(dmat, axis=-1))
        wts = jnp.exp(dmat - m_t[..., None]) * jnp.einsum('bhtd,bhsd->bhts', qc, kc)
        inter = jnp.exp(g - m_t)
        num = jnp.einsum('bhts,bhsd->bhtd', wts, vc) + inter[..., None] * jnp.einsum('bhtd,bhde->bhte', qc, C)
        den = jnp.sum(wts, axis=-1) + inter * jnp.einsum('bhtd,bhd->bht', qc, n)
        h = num / jnp.maximum(jnp.abs(den), jnp.exp(-m_t))[..., None]
        m_new = m_t[..., -1]
        decay = jnp.exp(b[..., -1:] - b + ic - m_new[..., None])
        carry_scale = jnp.exp(b[..., -1] + m - m_new)
        C_new = carry_scale[..., None, None] * C + jnp.einsum('bhs,bhsd,bhse->bhde', decay, kc, vc)
        n_new = carry_scale[..., None] * n + jnp.einsum('bhs,bhsd->bhd', decay, kc)
        return (C_new, n_new, m_new), h

    final, hs = lax.scan(step, state, (to_chunks(q), to_chunks(k), to_chunks(v),
                                       to_chunks(i_pre), to_chunks(log_f)))
    h = jnp.moveaxis(hs, 0, 2).reshape(bsz, nh, n_tok, dh)
    return h, final


def mlstm_mixer(u_lat, u_ctx, w_in, conv_w, conv_b, wq, wk, wv, gate_w, gate_b, mhn_g, skip, w_out, need_ctx):
    bsz = u_lat.shape[0]
    dt = u_lat.dtype

    def dwconv(t):
        y = lax.conv_general_dilated(t, conv_w[:, None, :], window_strides=(1,), padding=[MLSTM_CONV_PAD],
                                     dimension_numbers=('NWC', 'WIO', 'NWC'), feature_group_count=D_INNER)
        return y + conv_b

    def headwise(t, w):
        tb = t.reshape(*t.shape[:-1], QKV_NBLK, QKV_BLOCK)
        return jnp.einsum('btnd,nde->btne', tb, w).reshape(t.shape)

    def to_heads(t):
        n = t.shape[1]
        return jnp.transpose(t.reshape(bsz, n, MLSTM_HEADS, MLSTM_DH), (0, 2, 1, 3)).astype(F32)

    def branch(u):
        xm, z, og = jnp.split(u @ w_in, 3, axis=-1)
        xc = jax.nn.silu(dwconv(xm))
        q = headwise(xc, wq)
        k = headwise(xc, wk)
        v = headwise(xm, wv)
        gin = jnp.concatenate([q, k, v], axis=-1).astype(F32)
        gates = []
        for d in range(2):
            pre = gin @ gate_w[d].astype(F32) + gate_b[d].astype(F32)
            i_pre = jnp.transpose(pre[..., :MLSTM_HEADS], (0, 2, 1))
            log_f = jax.nn.log_sigmoid(jnp.transpose(pre[..., MLSTM_HEADS:], (0, 2, 1)))
            gates.append((i_pre, log_f))
        qkv = (to_heads(q), to_heads(k) * (MLSTM_DH ** -0.5), to_heads(v))
        return xc, z, og, qkv, gates

    xc_l, z_l, og_l, qkv_l, gates_l = branch(u_lat)
    xc_c, z_c, og_c, qkv_c, gates_c = branch(u_ctx)

    zero = (jnp.zeros((bsz, MLSTM_HEADS, MLSTM_DH, MLSTM_DH), F32),
            jnp.zeros((bsz, MLSTM_HEADS, MLSTM_DH), F32),
            jnp.zeros((bsz, MLSTM_HEADS), F32))
    flip = lambda t: jnp.flip(t, axis=2)
    hf_c, st_f = mlstm_chunk_scan(*qkv_c, *gates_c[0], zero)
    hf_l, _ = mlstm_chunk_scan(*qkv_l, *gates_l[0], st_f)
    hb_c, st_b = mlstm_chunk_scan(*[flip(t) for t in qkv_c], *[flip(t) for t in gates_c[1]], zero)
    hb_l, _ = mlstm_chunk_scan(*[flip(t) for t in qkv_l], *[flip(t) for t in gates_l[1]], st_b)

    def finish(h, og, xc, z):
        h = jnp.transpose(h, (0, 2, 1, 3))
        n = h.shape[1]
        h = h * jax.nn.sigmoid(og.astype(F32)).reshape(h.shape)
        mu = jnp.mean(h, axis=-1, keepdims=True)
        var = jnp.mean(jnp.square(h - mu), axis=-1, keepdims=True)
        hn = ((h - mu) * lax.rsqrt(var + EPS)).reshape(bsz, n, D_INNER) * mhn_g.astype(F32)
        y = (hn + skip.astype(F32) * xc.astype(F32)) * jax.nn.silu(z.astype(F32))
        return y.astype(dt) @ w_out

    out_l = finish(hf_l + flip(hb_l), og_l, xc_l, z_l)
    out_c = finish(hf_c + flip(hb_c), og_c, xc_c, z_c) if need_ctx else None
    return out_l, out_c


def setup_inputs(seed: int = 0) -> dict:
    key = jax.random.key(seed)
    ks = iter(jax.random.split(key, 48))

    def nrm(shape, s):
        return jax.random.normal(next(ks), shape, F32) * s

    D, E = D_MODEL, D_INNER
    n_a = len(range(0, DEPTH, N_MIXERS))
    n_b = len(range(1, DEPTH, N_MIXERS))
    n_c = len(range(2, DEPTH, N_MIXERS))
    f_bias = jnp.linspace(3.0, 6.0, MLSTM_HEADS, dtype=F32) + nrm((n_c, 2, MLSTM_HEADS), 0.1)
    i_bias = nrm((n_c, 2, MLSTM_HEADS), 0.1)
    return {
        "x": nrm((BATCH, SEQ, D), 1.0),
        "c": nrm((BATCH, D), 1.0),
        "ctx": nrm((BATCH, CTX_LEN, D), 1.0),
        "c_ctx": nrm((D,), 1.0),
        "mod_w": nrm((DEPTH, D, 3 * D), 0.5 * D ** -0.5),
        "mod_b": nrm((DEPTH, 3 * D), 0.02),
        "norm_g": 1.0 + nrm((DEPTH, D), 0.02),
        "a_w_in": nrm((n_a, D, 4 * E), D ** -0.5),
        "a_w_out": nrm((n_a, E, D), E ** -0.5),
        "a_qn_g": 1.0 + nrm((n_a, DIFF_DH), 0.02),
        "a_kn_g": 1.0 + nrm((n_a, DIFF_DH), 0.02),
        "a_lam": nrm((n_a, 4, DIFF_DH), 0.1),
        "a_subln_g": 1.0 + nrm((n_a, DIFF_VDH), 0.02),
        "b_w_in": nrm((n_b, D, 4 * E), D ** -0.5),
        "b_w_out": nrm((n_b, E, D), E ** -0.5),
        "b_qn_g": 1.0 + nrm((n_b, NA_DH), 0.02),
        "b_kn_g": 1.0 + nrm((n_b, NA_DH), 0.02),
        "b_rpb": nrm((n_b, NA_HEADS, 2 * NA_WIN_H - 1, 2 * NA_WIN_W - 1), 0.1),
        "c_w_in": nrm((n_c, D, 3 * E), D ** -0.5),
        "c_conv_w": nrm((n_c, MLSTM_CONV, E), MLSTM_CONV ** -0.5),
        "c_conv_b": nrm((n_c, E), 0.02),
        "c_wq": nrm((n_c, QKV_NBLK, QKV_BLOCK, QKV_BLOCK), QKV_BLOCK ** -0.5),
        "c_wk": nrm((n_c, QKV_NBLK, QKV_BLOCK, QKV_BLOCK), QKV_BLOCK ** -0.5),
        "c_wv": nrm((n_c, QKV_NBLK, QKV_BLOCK, QKV_BLOCK), QKV_BLOCK ** -0.5),
        "c_gate_w": nrm((n_c, 2, 3 * E, 2 * MLSTM_HEADS), (3 * E) ** -0.5),
        "c_gate_b": jnp.concatenate([i_bias, f_bias], axis=-1),
        "c_mhn_g": 1.0 + nrm((n_c, E), 0.02),
        "c_skip": 1.0 + nrm((n_c, E), 0.02),
        "c_w_out": nrm((n_c, E, D), E ** -0.5),
    }


def reference(x, c, ctx, c_ctx, mod_w, mod_b, norm_g,
              a_w_in, a_w_out, a_qn_g, a_kn_g, a_lam, a_subln_g,
              b_w_in, b_w_out, b_qn_g, b_kn_g, b_rpb,
              c_w_in, c_conv_w, c_conv_b, c_wq, c_wk, c_wv, c_gate_w, c_gate_b, c_mhn_g, c_skip, c_w_out):
    h_lat = x
    h_ctx = ctx
    for i in range(DEPTH):
        kind = i % N_MIXERS
        j = i // N_MIXERS
        need_ctx = i < DEPTH - 1
        shift, scale, gate = adaln(c, mod_w[i], mod_b[i])
        shift_c, scale_c, gate_c = adaln(c_ctx, mod_w[i], mod_b[i])
        u_lat = rms_norm(h_lat, norm_g[i]) * (1.0 + scale[:, None, :]) + shift[:, None, :]
        u_ctx = rms_norm(h_ctx, norm_g[i]) * (1.0 + scale_c) + shift_c
        if kind == 0:
            out_l, out_c = diff_attention_mixer(u_lat, u_ctx, a_w_in[j], a_w_out[j], a_qn_g[j], a_kn_g[j],
                                                a_lam[j], a_subln_g[j], i, need_ctx)
        elif kind == 1:
            out_l, out_c = neighbourhood_mixer(u_lat, u_ctx, b_w_in[j], b_w_out[j], b_qn_g[j], b_kn_g[j],
                                               b_rpb[j], need_ctx)
        else:
            out_l, out_c = mlstm_mixer(u_lat, u_ctx, c_w_in[j], c_conv_w[j], c_conv_b[j], c_wq[j], c_wk[j],
                                       c_wv[j], c_gate_w[j], c_gate_b[j], c_mhn_g[j], c_skip[j], c_w_out[j],
                                       need_ctx)
        h_lat = h_lat + gate[:, None, :] * out_l
        if need_ctx:
            h_ctx = h_ctx + gate_c * out_c
    return h_lat
```

```cpp
#include <hip/hip_runtime.h>
#include <hip/hip_cooperative_groups.h>
#include <stdint.h>
#include <stdio.h>
namespace cg = cooperative_groups;

typedef unsigned short bf16_t;
typedef short bf16x8 __attribute__((ext_vector_type(8)));
typedef short bf16x4 __attribute__((ext_vector_type(4)));
typedef float f32x2 __attribute__((ext_vector_type(2)));
typedef float f32x4 __attribute__((ext_vector_type(4)));
typedef float f32x16 __attribute__((ext_vector_type(16)));
typedef __bf16 bf16x2v __attribute__((ext_vector_type(2)));
typedef unsigned u32x2 __attribute__((ext_vector_type(2)));
typedef unsigned u32x4 __attribute__((ext_vector_type(4)));

#define DI __device__ __forceinline__
#define MFMA32(a, b, c) __builtin_amdgcn_mfma_f32_32x32x16_bf16((a), (b), (c), 0, 0, 0)
#define MFMA16(a, b, c) __builtin_amdgcn_mfma_f32_16x16x32_bf16((a), (b), (c), 0, 0, 0)

constexpr int DM = 1024;
constexpr int EI = 2048;
constexpr int NBATCH = 8;
constexpr int SEQ = 2048;
constexpr int CTXL = 256;
constexpr int TPB = SEQ + CTXL;
constexpr int NTOK = NBATCH * TPB;
constexpr int GB = 4;
constexpr int GT = GB * TPB;
constexpr int NGROUP = NBATCH / GB;
constexpr float EPS = 1e-6f;
constexpr int NTHREADS = 512;
constexpr size_t BUFE = (size_t)GT * EI;
constexpr int NCHUNK = TPB / 64;
constexpr int LDS_BYTES = 120 * 1024;

enum { PH_MOD = 0, PH_PREP, PH_AB_INPROJ, PH_AB_QKNORM, PH_A_ATTN, PH_B_ATTN, PH_OUTPROJ, PH_C_INPROJ, PH_C_PRE, PH_C_SCAN, PH_C_ZOG, PH_C_FINISH };
constexpr int MAX_PHASES = 64;
#ifndef PH_LIMIT
#define PH_LIMIT 1000
#endif

struct Params {
    const float *x, *c, *ctx, *c_ctx, *mod_w, *mod_b, *norm_g;
    const float *a_w_in, *a_w_out, *a_qn_g, *a_kn_g, *a_lam, *a_subln_g;
    const float *b_w_in, *b_w_out, *b_qn_g, *b_kn_g, *b_rpb;
    const float *c_w_in, *c_conv_w, *c_conv_b, *c_wq, *c_wk, *c_wv, *c_gate_w, *c_gate_b, *c_mhn_g, *c_skip, *c_w_out;
    float* out;
    float* mod;
    float* hctx;
    bf16_t* win;
    bf16_t* wout;
    bf16_t* u;
    bf16_t* buf[5];
    float* sbuf;
    float* gates;
    int nphases;
    int pad_;
    int prog[MAX_PHASES];
};

#define TIDX (tid_opaque)
#define BIDX (bid_opaque)
DI unsigned pack2(float lo, float hi) { f32x2 v = {lo, hi}; bf16x2v b = __builtin_convertvector(v, bf16x2v); return __builtin_bit_cast(unsigned, b); }
DI bf16_t f2bf(float x) { return (bf16_t)(pack2(x, 0.f) & 0xffffu); }
DI float bf2f(bf16_t v) { return __uint_as_float(((unsigned)v) << 16); }
DI float bflo(unsigned w) { return __uint_as_float(w << 16); }
DI float bfhi(unsigned w) { return __uint_as_float(w & 0xffff0000u); }
DI float shx(float v, int o, int lane) { return __uint_as_float((unsigned)__builtin_amdgcn_ds_bpermute((lane ^ o) << 2, (int)__float_as_uint(v))); }
DI float shl_from(float v, int src_lane) { return __uint_as_float((unsigned)__builtin_amdgcn_ds_bpermute((src_lane & 63) << 2, (int)__float_as_uint(v))); }
DI float wave_sum(float v, int lane) {
#pragma unroll
    for (int o = 32; o; o >>= 1) v += shx(v, o, lane);
    return v;
}
DI float wave_max(float v, int lane) {
#pragma unroll
    for (int o = 32; o; o >>= 1) v = fmaxf(v, shx(v, o, lane));
    return v;
}
DI float silu_f(float x) { return x / (1.f + __expf(-x)); }
DI float sigmoid_f(float x) { return 1.f / (1.f + __expf(-x)); }
DI bf16x8 pack_acc(const f32x16& x, int s) {
    u32x4 p;
    p[0] = pack2(x[8 * s + 0], x[8 * s + 1]); p[1] = pack2(x[8 * s + 2], x[8 * s + 3]);
    p[2] = pack2(x[8 * s + 4], x[8 * s + 5]); p[3] = pack2(x[8 * s + 6], x[8 * s + 7]);
    return __builtin_bit_cast(bf16x8, p);
}
DI bf16x8 cat4(bf16x4 lo, bf16x4 hi) { bf16x8 r; r[0] = lo[0]; r[1] = lo[1]; r[2] = lo[2]; r[3] = lo[3]; r[4] = hi[0]; r[5] = hi[1]; r[6] = hi[2]; r[7] = hi[3]; return r; }
DI int launder(int x) { asm volatile("" : "+v"(x)); return x; }
DI int launder_s(int x) { asm volatile("" : "+s"(x)); return x; }
DI f32x16 zero16() { f32x16 z; for (int i = 0; i < 16; ++i) z[i] = 0.f; return z; }

DI float* resid_ptr(const Params& p, int layer_src_is_input, int R, int& v) {
    const int b = R / TPB, t = R - b * TPB;
    if (t < SEQ) { v = b; return (float*)(layer_src_is_input ? p.x : p.out) + ((size_t)b * SEQ + t) * DM; }
    v = 8; return (float*)(layer_src_is_input ? p.ctx : p.hctx) + ((size_t)b * CTXL + (t - SEQ)) * DM;
}

__device__ void phase_mod(int tid_opaque, int bid_opaque, const Params& p, char* ldsc) {
    float* sc = (float*)ldsc;
    float* red = sc + 9 * 1024;
    const int tid = TIDX, lane = tid & 63, w = tid >> 6;
    for (int i = tid; i < 9 * 1024; i += NTHREADS) { const int v = i >> 10, k = i & 1023; const float cv = v < 8 ? p.c[v * 1024 + k] : p.c_ctx[k]; sc[i] = silu_f(cv); }
    __syncthreads();
    for (int unit = BIDX; unit < 4 * 48; unit += gridDim.x) {
        const int l = unit / 48, n0 = (unit % 48) * 64;
        float acc[9];
#pragma unroll
        for (int v = 0; v < 9; ++v) acc[v] = 0.f;
        const float* wp = p.mod_w + (size_t)l * 1024 * 3072 + n0 + lane;
        for (int k = w; k < 1024; k += 8) {
            const float wv = wp[(size_t)k * 3072];
#pragma unroll
            for (int v = 0; v < 9; ++v) acc[v] += sc[v * 1024 + k] * wv;
        }
#pragma unroll
        for (int v = 0; v < 9; ++v) red[(w * 9 + v) * 64 + lane] = acc[v];
        __syncthreads();
        for (int i = tid; i < 9 * 64; i += NTHREADS) {
            const int v = i >> 6, col = i & 63; float s = 0.f;
#pragma unroll
            for (int ww = 0; ww < 8; ++ww) s += red[(ww * 9 + v) * 64 + col];
            p.mod[(l * 9 + v) * 3072 + n0 + col] = s + p.mod_b[l * 3072 + n0 + col];
        }
        __syncthreads();
    }
}

__device__ void phase_norm(int tid_opaque, int bid_opaque, const Params& p, int layer) {
    const int tid = TIDX, lane = tid & 63;
    const int gw = BIDX * 8 + (tid >> 6), nw = gridDim.x * 8;
    const float* g = p.norm_g + layer * DM;
    for (int R = gw; R < NTOK; R += nw) {
        int v; const float* src = resid_ptr(p, layer == 0, R, v);
        const float* mv = p.mod + (layer * 9 + v) * 3072;
        f32x4 xv[4]; float ss = 0.f;
#pragma unroll
        for (int i = 0; i < 4; ++i) { xv[i] = *(const f32x4*)(src + i * 256 + lane * 4); ss += xv[i][0] * xv[i][0] + xv[i][1] * xv[i][1] + xv[i][2] * xv[i][2] + xv[i][3] * xv[i][3]; }
        ss = wave_sum(ss, lane);
        const float rstd = rsqrtf(ss * (1.f / DM) + EPS);
#pragma unroll
        for (int i = 0; i < 4; ++i) {
            const int col = i * 256 + lane * 4;
            const f32x4 gg = *(const f32x4*)(g + col), sh = *(const f32x4*)(mv + col), scl = *(const f32x4*)(mv + 1024 + col);
            f32x4 y;
#pragma unroll
            for (int e = 0; e < 4; ++e) y[e] = xv[i][e] * rstd * gg[e] * (1.f + scl[e]) + sh[e];
            u32x2 o; o[0] = pack2(y[0], y[1]); o[1] = pack2(y[2], y[3]);
            *(u32x2*)(p.u + (size_t)R * DM + col) = o;
        }
    }
}

__device__ void phase_wconv(int tid_opaque, int bid_opaque, const float* W, bf16_t* Wt, int K, int N, char* ldsc) {
    bf16_t* t = (bf16_t*)ldsc;
    const int tid = TIDX;
    const int tilesN = N / 64, tiles = (K / 64) * tilesN;
    for (int unit = BIDX; unit < tiles; unit += gridDim.x) {
        const int k0 = (unit / tilesN) * 64, n0 = (unit % tilesN) * 64;
        const int nn = (tid & 15) * 4;
#pragma unroll
        for (int hh = 0; hh < 2; ++hh) {
            const int kk = (tid >> 4) + 32 * hh;
            const f32x4 v = *(const f32x4*)(W + (size_t)(k0 + kk) * N + n0 + nn);
            t[(nn + 0) * 72 + kk] = f2bf(v[0]); t[(nn + 1) * 72 + kk] = f2bf(v[1]); t[(nn + 2) * 72 + kk] = f2bf(v[2]); t[(nn + 3) * 72 + kk] = f2bf(v[3]);
        }
        __syncthreads();
        { const int n = tid >> 3, k8 = (tid & 7) * 8; *(u32x4*)(Wt + (size_t)(n0 + n) * K + k0 + k8) = *(const u32x4*)(t + n * 72 + k8); }
        __syncthreads();
    }
}

template <class Epi>
__device__ void gemm_bt(int tid_opaque, int bid_opaque, const bf16_t* A, const bf16_t* Bt, int M, int N, int K, const Epi& epi, char* lds) {
    constexpr int RS = 144;
    constexpr int TB = 128 * RS;
    const int tid = TIDX, lane = tid & 63, w = tid >> 6, wm = w >> 1, wn = w & 1;
    const int ldrow = tid >> 2, ldc = (tid & 3) * 2;
    const int tilesN = N / 128, nunits = (M / 128) * tilesN, nk = K / 64;
    for (int unit = BIDX; unit < nunits; unit += gridDim.x) {
        const int m0 = (unit / tilesN) * 128, n0 = (unit % tilesN) * 128;
        const bf16_t* ga = A + (size_t)(m0 + ldrow) * K + ldc * 8;
        const bf16_t* gb = Bt + (size_t)(n0 + ldrow) * K + ldc * 8;
        f32x4 acc[2][4];
#pragma unroll
        for (int i = 0; i < 2; ++i)
#pragma unroll
            for (int j = 0; j < 4; ++j) acc[i][j] = (f32x4){0.f, 0.f, 0.f, 0.f};
        u32x4 ra0 = *(const u32x4*)ga, ra1 = *(const u32x4*)(ga + 8), rb0 = *(const u32x4*)gb, rb1 = *(const u32x4*)(gb + 8);
        {
            char* sa = lds + ldrow * RS + ldc * 16; char* sb = lds + TB + ldrow * RS + ldc * 16;
            *(u32x4*)sa = ra0; *(u32x4*)(sa + 16) = ra1; *(u32x4*)sb = rb0; *(u32x4*)(sb + 16) = rb1;
        }
        __syncthreads();
        for (int kt = 0; kt < nk; ++kt) {
            const int cur = kt & 1;
            if (kt + 1 < nk) { const bf16_t* a2 = ga + (kt + 1) * 64; const bf16_t* b2 = gb + (kt + 1) * 64; ra0 = *(const u32x4*)a2; ra1 = *(const u32x4*)(a2 + 8); rb0 = *(const u32x4*)b2; rb1 = *(const u32x4*)(b2 + 8); }
            const char* sA = lds + cur * 2 * TB; const char* sB = sA + TB;
#pragma unroll
            for (int ks = 0; ks < 2; ++ks) {
                bf16x8 af[2], bfr[4];
#pragma unroll
                for (int mt = 0; mt < 2; ++mt) af[mt] = *(const bf16x8*)(sA + (wm * 32 + mt * 16 + (lane & 15)) * RS + ks * 64 + (lane >> 4) * 16);
#pragma unroll
                for (int nt = 0; nt < 4; ++nt) bfr[nt] = *(const bf16x8*)(sB + (wn * 64 + nt * 16 + (lane & 15)) * RS + ks * 64 + (lane >> 4) * 16);
#pragma unroll
                for (int mt = 0; mt < 2; ++mt)
#pragma unroll
                    for (int nt = 0; nt < 4; ++nt) acc[mt][nt] = MFMA16(bfr[nt], af[mt], acc[mt][nt]);
            }
            if (kt + 1 < nk) {
                char* sa = lds + (cur ^ 1) * 2 * TB + ldrow * RS + ldc * 16; char* sb = sa + TB;
                *(u32x4*)sa = ra0; *(u32x4*)(sa + 16) = ra1; *(u32x4*)sb = rb0; *(u32x4*)(sb + 16) = rb1;
            }
            __syncthreads();
        }
#pragma unroll
        for (int mt = 0; mt < 2; ++mt)
#pragma unroll
            for (int nt = 0; nt < 4; ++nt) epi(m0 + wm * 32 + mt * 16 + (lane & 15), n0 + wn * 64 + nt * 16 + (lane >> 4) * 4, acc[mt][nt]);
    }
}

struct EpiBf16 {
    bf16_t* out; int ld; float scale;
    DI void operator()(int row, int col, f32x4 v) const { u32x2 o; o[0] = pack2(v[0] * scale, v[1] * scale); o[1] = pack2(v[2] * scale, v[3] * scale); *(u32x2*)(out + (size_t)row * ld + col) = o; }
};
struct EpiResid {
    const Params* p; int layer; int row_off; int lat_only;
    DI void operator()(int row, int col, f32x4 v) const {
        const int R = row_off + row; int mvi;
        const int b = R / TPB, t = R - b * TPB;
        if (lat_only && t >= SEQ) return;
        const float* src = resid_ptr(*p, layer == 0, R, mvi);
        float* dst = (t < SEQ) ? p->out + ((size_t)b * SEQ + t) * DM : p->hctx + ((size_t)b * CTXL + (t - SEQ)) * DM;
        const f32x4 g = *(const f32x4*)(p->mod + (layer * 9 + mvi) * 3072 + 2048 + col);
        const f32x4 base = *(const f32x4*)(src + col);
        f32x4 o;
#pragma unroll
        for (int e = 0; e < 4; ++e) o[e] = base[e] + g[e] * v[e];
        *(f32x4*)(dst + col) = o;
    }
};

DI void sincos_rr(float x, float& s, float& c) {
    const float n = rintf(x * 0.15915494309f);
    float r = fmaf(-n, 6.2831855f, x); r = fmaf(-n, -1.7484555e-7f, r);
    s = __sinf(r); c = __cosf(r);
}
__device__ void phase_qknorm(int tid_opaque, int bid_opaque, const Params& p, bf16_t* Q, bf16_t* K, const float* qg, const float* kg, int rope) {
    const int tid = TIDX, lane = tid & 63, half = lane & 1;
    const int gw = BIDX * 8 + (tid >> 6), nw = gridDim.x * 8;
    for (int task = gw; task < 2 * GT; task += nw) {
        const int which = task & 1, r = task >> 1;
        bf16_t* base = (which ? K : Q) + (size_t)r * EI + lane * 32;
        const float* g = (which ? kg : qg) + half * 32;
        u32x4 raw[4];
#pragma unroll
        for (int i = 0; i < 4; ++i) raw[i] = *(const u32x4*)(base + i * 8);
        float y[32]; float ss = 0.f;
#pragma unroll
        for (int i = 0; i < 4; ++i)
#pragma unroll
            for (int e = 0; e < 4; ++e) { y[i * 8 + 2 * e] = bflo(raw[i][e]); y[i * 8 + 2 * e + 1] = bfhi(raw[i][e]); }
#pragma unroll
        for (int d = 0; d < 32; ++d) ss += y[d] * y[d];
        ss += shx(ss, 1, lane);
        const float rstd = rsqrtf(ss * (1.f / 64.f) + EPS);
#pragma unroll
        for (int d = 0; d < 32; ++d) y[d] = y[d] * rstd * g[d];
        const int t = r % TPB;
        if (rope && t < SEQ) {
            const float pos = (float)(half ? (t & 63) : (t >> 6));
#pragma unroll
            for (int i = 0; i < 16; ++i) {
                const float inv = exp2f(-(float)i * (13.287712379549449f / 16.f));
                float s, c; sincos_rr(pos * inv, s, c);
                const float a = y[i], b = y[i + 16];
                y[i] = a * c - b * s; y[i + 16] = b * c + a * s;
            }
        }
#pragma unroll
        for (int i = 0; i < 4; ++i) { u32x4 o;
#pragma unroll
            for (int e = 0; e < 4; ++e) o[e] = pack2(y[i * 8 + 2 * e], y[i * 8 + 2 * e + 1]);
            *(u32x4*)(base + i * 8) = o; }
    }
}

__device__ void phase_attn_a(int tid_opaque, int bid_opaque, const Params& p, int layer, int j, int need_ctx, char* lds) {
    const int tid = TIDX, lane = tid & 63, w = tid >> 6, li = lane & 31, h = lane >> 5;
    bf16_t* Q = p.buf[0]; const bf16_t* Kb = p.buf[1]; const bf16_t* VT = p.buf[2]; const bf16_t* Z = p.buf[3];
    const float* lv = p.a_lam + j * 256;
    const float d1 = wave_sum(lv[lane] * lv[64 + lane], lane), d2 = wave_sum(lv[128 + lane] * lv[192 + lane], lane);
    const float lam_init = 0.8f - 0.6f * expf(-0.3f * (float)layer);
    const float lam = expf(d1) - expf(d2) + lam_init;
    const float gqm = wave_max(fabsf(p.a_qn_g[j * 64 + lane]), lane), gkm = wave_max(fabsf(p.a_kn_g[j * 64 + lane]), lane);
    const float c1 = 0.125f * 1.4426950408889634f, c2 = 8.f * gqm * gkm * 1.4426950408889634f;
    const float* sg = p.a_subln_g + j * 128;
    const int nlat = GB * 16 * 8, nunits = nlat + (need_ctx ? GB * 16 : 0);
    for (int unit = BIDX; unit < nunits; unit += gridDim.x) {
        int bl, vh, q0, kb0, kb1;
        if (unit < nlat) { bl = unit >> 7; vh = (unit >> 3) & 15; q0 = (unit & 7) * 256 + w * 32; kb0 = 0; kb1 = TPB / 32; }
        else { const int u2 = unit - nlat; bl = u2 >> 4; vh = u2 & 15; q0 = SEQ + w * 32; kb0 = SEQ / 32; kb1 = TPB / 32; }
        const size_t qoff = ((size_t)(bl * TPB + q0 + li)) * EI + vh * 128;
        char* qs = lds + w * (32 * 272);
#pragma unroll
        for (int i = 0; i < 8; ++i) { const int rr = i * 4 + (lane >> 4), c16 = lane & 15; *(u32x4*)(qs + rr * 272 + c16 * 16) = *(const u32x4*)(Q + ((size_t)(bl * TPB + q0 + rr)) * EI + vh * 128 + c16 * 8); }
        f32x16 O1[4], O2[4];
#pragma unroll
        for (int d = 0; d < 4; ++d) { O1[d] = zero16(); O2[d] = zero16(); }
        float l1 = 0.f, l2 = 0.f;
        for (int kb = kb0; kb < kb1; ++kb) {
            const int lane_ = launder(lane), li = lane_ & 31, h = lane_ >> 5;
            const char* qrd = qs + li * 272 + h * 16;
            const bf16_t* kp = Kb + ((size_t)(bl * TPB + kb * 32 + li)) * EI + vh * 128 + h * 8;
            bf16x8 pf1[2], pf2[2];
            {
                f32x16 S = zero16();
#pragma unroll
                for (int s = 0; s < 4; ++s) S = MFMA32(*(const bf16x8*)(kp + s * 16), *(const bf16x8*)(qrd + s * 32), S);
                float ps = 0.f;
#pragma unroll
                for (int r = 0; r < 16; ++r) { const float e = __builtin_amdgcn_exp2f(S[r] * c1 - c2); S[r] = e; ps += e; }
                l1 += ps; pf1[0] = pack_acc(S, 0); pf1[1] = pack_acc(S, 1);
            }
            {
                f32x16 S = zero16();
#pragma unroll
                for (int s = 0; s < 4; ++s) S = MFMA32(*(const bf16x8*)(kp + 64 + s * 16), *(const bf16x8*)(qrd + 128 + s * 32), S);
                float ps = 0.f;
#pragma unroll
                for (int r = 0; r < 16; ++r) { const float e = __builtin_amdgcn_exp2f(S[r] * c1 - c2); S[r] = e; ps += e; }
                l2 += ps; pf2[0] = pack_acc(S, 0); pf2[1] = pack_acc(S, 1);
            }
            const bf16_t* vp = VT + ((size_t)(vh * 128 + li)) * GT + bl * TPB + kb * 32 + 4 * h;
#pragma unroll
            for (int d = 0; d < 4; ++d)
#pragma unroll
                for (int s = 0; s < 2; ++s) {
                    const bf16x8 vf = cat4(*(const bf16x4*)(vp + (size_t)d * 32 * GT + 16 * s), *(const bf16x4*)(vp + (size_t)d * 32 * GT + 16 * s + 8));
                    O1[d] = MFMA32(vf, pf1[s], O1[d]); O2[d] = MFMA32(vf, pf2[s], O2[d]);
                }
        }
        l1 += shx(l1, 32, lane); l2 += shx(l2, 32, lane);
        const float i1 = 1.f / l1, i2 = lam / l2;
        float ss = 0.f;
#pragma unroll
        for (int d = 0; d < 4; ++d)
#pragma unroll
            for (int r = 0; r < 16; ++r) { const float o = O1[d][r] * i1 - O2[d][r] * i2; O1[d][r] = o; ss += o * o; }
        ss += shx(ss, 32, lane);
        const float rs = rsqrtf(ss * (1.f / 128.f) + EPS) * (1.f - lam_init);
#pragma unroll
        for (int d = 0; d < 4; ++d)
#pragma unroll
            for (int g4 = 0; g4 < 4; ++g4) {
                const int dd = d * 32 + 8 * g4 + 4 * h;
                const u32x2 zr = *(const u32x2*)(Z + qoff + dd);
                const f32x4 sgv = *(const f32x4*)(sg + dd);
                const float z0 = bflo(zr[0]), z1 = bfhi(zr[0]), z2 = bflo(zr[1]), z3 = bfhi(zr[1]);
                u32x2 o;
                o[0] = pack2(O1[d][4 * g4 + 0] * rs * sgv[0] * silu_f(z0), O1[d][4 * g4 + 1] * rs * sgv[1] * silu_f(z1));
                o[1] = pack2(O1[d][4 * g4 + 2] * rs * sgv[2] * silu_f(z2), O1[d][4 * g4 + 3] * rs * sgv[3] * silu_f(z3));
                *(u32x2*)(Q + qoff + dd) = o;
            }
    }
}

__device__ void phase_attn_b(int tid_opaque, int bid_opaque, const Params& p, int need_ctx) {
    const int tid = TIDX, lane = tid & 63, w = tid >> 6, li = lane & 31, h = lane >> 5;
    bf16_t* Q = p.buf[0]; const bf16_t* Kb = p.buf[1]; const bf16_t* VT = p.buf[2]; const bf16_t* Z = p.buf[3];
    const float gqm = wave_max(fabsf(p.b_qn_g[lane]), lane), gkm = wave_max(fabsf(p.b_kn_g[lane]), lane);
    const float L2E = 1.4426950408889634f;
    const int nlat = GB * 32 * 8, nunits = nlat + (need_ctx ? GB * 32 : 0);
    for (int unit = BIDX; unit < nunits; unit += gridDim.x) {
        int bl, head, q0, row = 0, hf = 0; bool isctx;
        if (unit < nlat) { bl = unit >> 8; head = (unit >> 3) & 31; row = (unit & 7) * 4 + (w >> 1); hf = w & 1; q0 = row * 64 + hf * 32; isctx = false; }
        else { const int u2 = unit - nlat; bl = u2 >> 5; head = u2 & 31; q0 = SEQ + w * 32; isctx = true; }
        const float* rp = p.b_rpb + head * 465;
        float bm = 0.f;
        for (int i = lane; i < 465; i += 64) bm = fmaxf(bm, fabsf(rp[i]));
        bm = wave_max(bm, lane);
        const float c2 = (8.f * gqm * gkm + bm) * L2E;
        const size_t qoff = ((size_t)(bl * TPB + q0 + li)) * EI + head * 64;
        bf16x8 qf[4];
#pragma unroll
        for (int s = 0; s < 4; ++s) qf[s] = *(const bf16x8*)(Q + qoff + s * 16 + h * 8);
        f32x16 O[2]; O[0] = zero16(); O[1] = zero16();
        float l = 0.f;
        const int rs = isctx ? 0 : min(max(row - 4, 0), 24);
        const int qc = hf * 32 + li, ws = min(max(qc - 8, 0), 48);
        const int nblk = isctx ? 8 : 24;
        for (int kbi = 0; kbi < nblk; ++kbi) {
            int ktok; bool win = false; int cb = 0, wr = 0;
            if (!isctx && kbi < 16) { wr = kbi >> 1; cb = kbi & 1; ktok = (rs + wr) * 64 + cb * 32; win = true; }
            else ktok = SEQ + (isctx ? kbi : kbi - 16) * 32;
            const bf16_t* kp = Kb + ((size_t)(bl * TPB + ktok + li)) * EI + head * 64 + h * 8;
            f32x16 S = zero16();
#pragma unroll
            for (int s = 0; s < 4; ++s) S = MFMA32(*(const bf16x8*)(kp + s * 16), qf[s], S);
            float ps = 0.f;
            if (win) {
                const float* rrow = rp + (rs + wr - row + 7) * 31;
#pragma unroll
                for (int r = 0; r < 16; ++r) {
                    const int kc = cb * 32 + (r & 3) + 8 * (r >> 2) + 4 * h;
                    const bool valid = (kc >= ws) && (kc < ws + 16);
                    const int bi = min(max(kc - qc + 15, 0), 30);
                    const float e = valid ? __builtin_amdgcn_exp2f((S[r] * 0.125f + rrow[bi]) * L2E - c2) : 0.f;
                    S[r] = e; ps += e;
                }
            } else {
#pragma unroll
                for (int r = 0; r < 16; ++r) { const float e = __builtin_amdgcn_exp2f(S[r] * (0.125f * L2E) - c2); S[r] = e; ps += e; }
            }
            l += ps;
            const bf16x8 pf0 = pack_acc(S, 0), pf1 = pack_acc(S, 1);
            const bf16_t* vp = VT + ((size_t)(head * 64 + li)) * GT + bl * TPB + ktok + 4 * h;
#pragma unroll
            for (int d = 0; d < 2; ++d) {
                const bf16x8 v0 = cat4(*(const bf16x4*)(vp + (size_t)d * 32 * GT), *(const bf16x4*)(vp + (size_t)d * 32 * GT + 8));
                const bf16x8 v1 = cat4(*(const bf16x4*)(vp + (size_t)d * 32 * GT + 16), *(const bf16x4*)(vp + (size_t)d * 32 * GT + 24));
                O[d] = MFMA32(v0, pf0, O[d]); O[d] = MFMA32(v1, pf1, O[d]);
            }
        }
        l += shx(l, 32, lane);
        const float il = 1.f / l;
#pragma unroll
        for (int d = 0; d < 2; ++d)
#pragma unroll
            for (int g4 = 0; g4 < 4; ++g4) {
                const int dd = d * 32 + 8 * g4 + 4 * h;
                const u32x2 zr = *(const u32x2*)(Z + qoff + dd);
                u32x2 o;
                o[0] = pack2(O[d][4 * g4 + 0] * il * silu_f(bflo(zr[0])), O[d][4 * g4 + 1] * il * silu_f(bfhi(zr[0])));
                o[1] = pack2(O[d][4 * g4 + 2] * il * silu_f(bflo(zr[1])), O[d][4 * g4 + 3] * il * silu_f(bfhi(zr[1])));
                *(u32x2*)(Q + qoff + dd) = o;
            }
    }
}

DI int chunk_tok0(int cidx) { return cidx < 32 ? cidx * 64 : SEQ + (cidx - 32) * 64; }

__device__ void phase_c_pre(int tid_opaque, int bid_opaque, const Params& p, char* lds) {
    constexpr int XS = 272;
    char* xs = lds;
    char* qs = lds + 18432;
    char* ks = qs + 64 * XS;
    float* red = (float*)(ks + 64 * XS);
    const int tid0 = TIDX;
    const bf16_t* XM = p.buf[0]; bf16_t* Q = p.buf[1]; bf16_t* KT = p.buf[2];
    const float kscale = 0.04419417382415922f;
    for (int unit = BIDX; unit < GB * NCHUNK * 4; unit += gridDim.x) {
        const int head = unit & 3, cidx = (unit >> 2) % NCHUNK, bl = unit / (4 * NCHUNK);
        const int tok0 = chunk_tok0(cidx), seq_lo = cidx < 32 ? 0 : SEQ, seq_hi = cidx < 32 ? SEQ : TPB;
        float gacc[16];
#pragma unroll
        for (int i = 0; i < 16; ++i) gacc[i] = 0.f;
        f32x16 Sacc = zero16();
        for (int cc = 0; cc < 4; ++cc) {
            const int tid = launder(tid0), lane = tid & 63, w = tid >> 6, li = lane & 31, h = lane >> 5;
            const int colbase = head * 512 + cc * 128;
            for (int ch = tid; ch < 67 * 16; ch += NTHREADS) {
                const int rr = ch >> 4, c16 = ch & 15, tt = tok0 - 2 + rr;
                u32x4 v = {0u, 0u, 0u, 0u};
                if (tt >= seq_lo && tt < seq_hi) v = *(const u32x4*)(XM + ((size_t)(bl * TPB + tt)) * EI + colbase + c16 * 8);
                *(u32x4*)(xs + rr * XS + c16 * 16) = v;
            }
            __syncthreads();
#pragma unroll 1
            for (int i = 0; i < 4; ++i) {
                const int nb = w + 8 * i, col = colbase + nb * 4, t = lane;
                float xr[4][4];
#pragma unroll
                for (int jj = 0; jj < 4; ++jj) { const u32x2 r2 = *(const u32x2*)(xs + (t + jj) * XS + nb * 8); xr[jj][0] = bflo(r2[0]); xr[jj][1] = bfhi(r2[0]); xr[jj][2] = bflo(r2[1]); xr[jj][3] = bfhi(r2[1]); }
                float xc[4];
                const f32x4 cb = *(const f32x4*)(p.c_conv_b + col);
#pragma unroll
                for (int e = 0; e < 4; ++e) xc[e] = cb[e];
#pragma unroll
                for (int jj = 0; jj < 4; ++jj) { const f32x4 cw = *(const f32x4*)(p.c_conv_w + jj * EI + col);
#pragma unroll
                    for (int e = 0; e < 4; ++e) xc[e] += cw[e] * xr[jj][e]; }
#pragma unroll
                for (int e = 0; e < 4; ++e) xc[e] = silu_f(xc[e]);
                const int blk = col >> 2;
                float qv[4] = {0.f, 0.f, 0.f, 0.f}, kv[4] = {0.f, 0.f, 0.f, 0.f}, vv[4] = {0.f, 0.f, 0.f, 0.f};
#pragma unroll
                for (int d = 0; d < 4; ++d) {
                    const f32x4 wq = *(const f32x4*)(p.c_wq + blk * 16 + d * 4), wk = *(const f32x4*)(p.c_wk + blk * 16 + d * 4), wv = *(const f32x4*)(p.c_wv + blk * 16 + d * 4);
#pragma unroll
                    for (int e = 0; e < 4; ++e) { qv[e] += xc[d] * wq[e]; kv[e] += xc[d] * wk[e]; vv[e] += xr[2][d] * wv[e]; }
                }
#pragma unroll
                for (int dir = 0; dir < 2; ++dir)
#pragma unroll
                    for (int e = 0; e < 4; ++e) {
                        asm volatile("" ::: "memory");
                        const float* g0 = p.c_gate_w + ((size_t)dir * 6144 + col + e) * 8;
                        const f32x4 a0 = *(const f32x4*)g0, a1 = *(const f32x4*)(g0 + 4);
                        const f32x4 b0 = *(const f32x4*)(g0 + 2048 * 8), b1 = *(const f32x4*)(g0 + 2048 * 8 + 4);
                        const f32x4 c0 = *(const f32x4*)(g0 + 4096 * 8), c1 = *(const f32x4*)(g0 + 4096 * 8 + 4);
#pragma unroll
                        for (int g = 0; g < 4; ++g) {
                            gacc[dir * 8 + g] += qv[e] * a0[g] + kv[e] * b0[g] + vv[e] * c0[g];
                            gacc[dir * 8 + 4 + g] += qv[e] * a1[g] + kv[e] * b1[g] + vv[e] * c1[g];
                        }
                    }
                u32x2 qo; qo[0] = pack2(qv[0], qv[1]); qo[1] = pack2(qv[2], qv[3]);
                u32x2 ko; ko[0] = pack2(kv[0] * kscale, kv[1] * kscale); ko[1] = pack2(kv[2] * kscale, kv[3] * kscale);
                *(u32x2*)(Q + ((size_t)(bl * TPB + tok0 + t)) * EI + col) = qo;
                *(u32x2*)(qs + t * XS + nb * 8) = qo;
                *(u32x2*)(ks + t * XS + nb * 8) = ko;
            }
            __syncthreads();
            if (w < 4) {
                const int tb = w >> 1, sb = w & 1;
#pragma unroll
                for (int kk = 0; kk < 8; ++kk) {
                    const bf16x8 a = *(const bf16x8*)(qs + (32 * tb + li) * XS + kk * 32 + h * 16);
                    const bf16x8 b = *(const bf16x8*)(ks + (32 * sb + li) * XS + kk * 32 + h * 16);
                    Sacc = MFMA32(a, b, Sacc);
                }
            }
            {
                const int d = tid >> 2, tq = (tid & 3) * 16;
                u32x4 o0, o1;
#pragma unroll
                for (int e = 0; e < 4; ++e) {
                    o0[e] = (unsigned)*(const bf16_t*)(ks + (tq + 2 * e) * XS + d * 2) | ((unsigned)*(const bf16_t*)(ks + (tq + 2 * e + 1) * XS + d * 2) << 16);
                    o1[e] = (unsigned)*(const bf16_t*)(ks + (tq + 8 + 2 * e) * XS + d * 2) | ((unsigned)*(const bf16_t*)(ks + (tq + 8 + 2 * e + 1) * XS + d * 2) << 16);
                }
                bf16_t* dst = KT + ((size_t)(colbase + d)) * GT + bl * TPB + tok0 + tq;
                *(u32x4*)dst = o0; *(u32x4*)(dst + 8) = o1;
            }
            __syncthreads();
        }
        const int tid = launder(tid0), lane = tid & 63, w = tid >> 6, li = lane & 31, h = lane >> 5;
        if (w < 4) {
            const int tb = w >> 1, sb = w & 1;
            float* So = p.sbuf + ((size_t)((bl * 4 + head) * NCHUNK + cidx)) * 4096;
#pragma unroll
            for (int r = 0; r < 16; ++r) So[(32 * tb + (r & 3) + 8 * (r >> 2) + 4 * h) * 64 + 32 * sb + li] = Sacc[r];
        }
#pragma unroll
        for (int i = 0; i < 16; ++i) red[(w * 64 + lane) * 16 + i] = gacc[i];
        __syncthreads();
        for (int o = tid; o < 1024; o += NTHREADS) {
            const int t = o >> 4, gi = o & 15; float s = 0.f;
#pragma unroll
            for (int ww = 0; ww < 8; ++ww) s += red[(ww * 64 + t) * 16 + gi];
            p.gates[((size_t)(bl * TPB + tok0 + t) * 4 + head) * 16 + gi] = s;
        }
        __syncthreads();
    }
}

__device__ void phase_c_scan(int tid_opaque, int bid_opaque, const Params& p, char* lds) {
    float* PART = (float*)lds;
    char* WTS = lds + 65536;
    char* VTL = WTS + 9216;
    char* DVT = VTL + 13824;
    float* SC = (float*)(DVT + 13824);
    float *bq = SC, *ig = SC + 64, *mtv = SC + 128, *interv = SC + 192, *einv = SC + 256, *decayv = SC + 320, *denv = SC + 384, *misc = SC + 448;
    const int tid0 = TIDX;
    const bf16_t* XM = p.buf[0]; const bf16_t* Q = p.buf[1]; const bf16_t* KT = p.buf[2];
    for (int item = BIDX; item < GB * 4 * 2 * 8; item += gridDim.x) {
        const int eb = item & 7, dir = (item >> 3) & 1, head = (item >> 4) & 3, bl = item >> 6;
        bf16_t* H = p.buf[3 + dir];
        f32x16 Cacc[2][3];
#pragma unroll
        for (int a = 0; a < 2; ++a)
#pragma unroll
            for (int b = 0; b < 3; ++b) Cacc[a][b] = zero16();
        float m_prev = 0.f;
        for (int i = tid0; i < 32 * 72; i += NTHREADS) {
            const int rr = 64 + i / 72, cc = i % 72;
            *(bf16_t*)(VTL + (rr * 72 + cc) * 2) = (rr == 64) ? (bf16_t)0x3F80 : (bf16_t)0;
            *(bf16_t*)(DVT + (rr * 72 + cc) * 2) = 0;
        }
        __syncthreads();
        for (int st = 0; st < NCHUNK; ++st) {
            const int tid = launder(tid0), lane = tid & 63, w = tid >> 6, li = lane & 31, h = lane >> 5;
            const int cidx = dir == 0 ? (st < 4 ? 32 + st : st - 4) : 35 - st;
            const int tok0 = chunk_tok0(cidx);
            const size_t rb = (size_t)bl * TPB + tok0;
            if (w == 0) {
                const int t = dir ? 63 - lane : lane;
                const float* gp = p.gates + (rb + t) * 64 + dir * 8 + head;
                float pi = p.c_gate_b[dir * 8 + head], pf = p.c_gate_b[dir * 8 + 4 + head];
#pragma unroll
                for (int hh = 0; hh < 4; ++hh) { pi += gp[hh * 16]; pf += gp[hh * 16 + 4]; }
                const float logf = fminf(pf, 0.f) - __logf(1.f + __expf(-fabsf(pf)));
                float b = logf;
#pragma unroll
                for (int o = 1; o < 64; o <<= 1) { const float v = shl_from(b, lane - o); if (lane >= o) b += v; }
                float pm = pi - b;
#pragma unroll
                for (int o = 1; o < 64; o <<= 1) { const float v = shl_from(pm, lane - o); if (lane >= o) pm = fmaxf(pm, v); }
                const float mt = b + fmaxf(m_prev, pm);
                const float blast = shl_from(b, 63), mnew = shl_from(mt, 63);
                bq[t] = b; ig[t] = pi; mtv[t] = mt;
                interv[t] = __expf(b + m_prev - mt); einv[t] = __expf(-mt); decayv[t] = __expf(blast - b + pi - mnew);
                if (lane == 0) { misc[0] = mnew; misc[1] = __expf(blast + m_prev - mnew); }
            }
            __syncthreads();
            const float carry = misc[1];
            m_prev = misc[0];
            {
                const int t = tid >> 3, s8 = (tid & 7) * 8;
                const float* Sp = p.sbuf + ((size_t)((bl * 4 + head) * NCHUNK + cidx)) * 4096 + t * 64 + s8;
                const f32x4 s0 = *(const f32x4*)Sp, s1 = *(const f32x4*)(Sp + 4);
                const float bt = bq[t] - mtv[t];
                float wv[8];
#pragma unroll
                for (int e = 0; e < 8; ++e) {
                    const int s = s8 + e; const bool valid = dir ? (s >= t) : (s <= t);
                    const float sv = e < 4 ? s0[e & 3] : s1[e & 3];
                    wv[e] = valid ? __expf(bt - bq[s] + ig[s]) * sv : 0.f;
                }
                u32x4 o; o[0] = pack2(wv[0], wv[1]); o[1] = pack2(wv[2], wv[3]); o[2] = pack2(wv[4], wv[5]); o[3] = pack2(wv[6], wv[7]);
                *(u32x4*)(WTS + t * 144 + s8 * 2) = o;
            }
#pragma unroll
            for (int i = 0; i < 2; ++i) {
                const int s = lane, nb = w + 8 * i, col = head * 512 + eb * 64 + nb * 4, blk = col >> 2;
                const u32x2 r2 = *(const u32x2*)(XM + (rb + s) * EI + col);
                const float x0 = bflo(r2[0]), x1 = bfhi(r2[0]), x2 = bflo(r2[1]), x3 = bfhi(r2[1]);
                const float dc = decayv[s];
#pragma unroll
                for (int e = 0; e < 4; ++e) {
                    const float* wvp = p.c_wv + blk * 16 + e;
                    const float v = x0 * wvp[0] + x1 * wvp[4] + x2 * wvp[8] + x3 * wvp[12];
                    *(bf16_t*)(VTL + ((nb * 4 + e) * 72 + s) * 2) = f2bf(v);
                    *(bf16_t*)(DVT + ((nb * 4 + e) * 72 + s) * 2) = f2bf(v * dc);
                }
            }
            if (tid < 64) *(bf16_t*)(DVT + (64 * 72 + tid) * 2) = f2bf(decayv[tid]);
            const bf16_t* qp0 = Q + (rb + li) * EI + head * 512 + 64 * w + 4 * h;
            __syncthreads();
#pragma unroll
            for (int eo = 0; eo < 3; ++eo) {
                const int ebk = eo == 0 ? 2 : eo - 1;
#pragma unroll
                for (int tb = 0; tb < 2; ++tb) {
                    f32x16 P = zero16();
#pragma unroll
                    for (int ks = 0; ks < 4; ++ks) {
                        const bf16x8 cf = pack_acc(Cacc[ks >> 1][ebk], ks & 1);
                        const bf16_t* qa = qp0 + (size_t)tb * 32 * EI + 32 * (ks >> 1) + 16 * (ks & 1);
                        P = MFMA32(cat4(*(const bf16x4*)qa, *(const bf16x4*)(qa + 8)), cf, P);
                    }
#pragma unroll
                    for (int r = 0; r < 16; ++r) P[r] *= interv[32 * tb + (r & 3) + 8 * (r >> 2) + 4 * h];
                    if ((w & 1) == tb) {
                        const int ksi = w >> 1;
                        const bf16x8 a = *(const bf16x8*)(WTS + (32 * tb + li) * 144 + ksi * 32 + h * 16);
                        const bf16x8 b = *(const bf16x8*)(VTL + (32 * ebk + li) * 144 + ksi * 32 + h * 16);
                        P = MFMA32(a, b, P);
                    }
#pragma unroll
                    for (int r = 0; r < 16; ++r) PART[w * 2048 + (32 * tb + (r & 3) + 8 * (r >> 2) + 4 * h) * 32 + li] = P[r];
                }
                __syncthreads();
                {
                    const int t = tid >> 3, e4 = (tid & 7) * 4;
                    f32x4 sum = {0.f, 0.f, 0.f, 0.f};
#pragma unroll
                    for (int ww = 0; ww < 8; ++ww) sum += *(const f32x4*)(PART + ww * 2048 + t * 32 + e4);
                    if (ebk == 2) { if (e4 == 0) denv[t] = sum[0]; }
                    else {
                        const float dn = 1.f / fmaxf(fabsf(denv[t]), einv[t]);
                        u32x2 o; o[0] = pack2(sum[0] * dn, sum[1] * dn); o[1] = pack2(sum[2] * dn, sum[3] * dn);
                        *(u32x2*)(H + (rb + t) * EI + head * 512 + eb * 64 + ebk * 32 + e4) = o;
                    }
                }
                __syncthreads();
            }
            {
#pragma unroll
                for (int db = 0; db < 2; ++db) {
                    bf16x8 kf[4];
#pragma unroll
                    for (int ks = 0; ks < 4; ++ks) kf[ks] = *(const bf16x8*)(KT + ((size_t)(head * 512 + 64 * w + 32 * db + li)) * GT + rb + 16 * ks + 8 * h);
#pragma unroll
                    for (int ebk = 0; ebk < 3; ++ebk) {
#pragma unroll
                        for (int r = 0; r < 16; ++r) Cacc[db][ebk][r] *= carry;
#pragma unroll
                        for (int ks = 0; ks < 4; ++ks) Cacc[db][ebk] = MFMA32(kf[ks], *(const bf16x8*)(DVT + (32 * ebk + li) * 144 + ks * 32 + h * 16), Cacc[db][ebk]);
                    }
                }
            }
            __syncthreads();
        }
    }
}

__device__ void phase_c_finish(int tid_opaque, int bid_opaque, const Params& p) {
    const int tid = TIDX, lane = tid & 63;
    const int gw = BIDX * 8 + (tid >> 6), nw = gridDim.x * 8;
    const bf16_t* XM = p.buf[0]; const bf16_t* Zb = p.buf[1]; const bf16_t* OG = p.buf[2]; bf16_t* HF = p.buf[3]; const bf16_t* HB = p.buf[4];
    for (int task = gw; task < GT * 4; task += nw) {
        const int head = task & 3, r = task >> 2, t = r % TPB;
        const int col = head * 512 + lane * 8;
        const size_t off = (size_t)r * EI + col;
        const u32x4 hf = *(const u32x4*)(HF + off), hb = *(const u32x4*)(HB + off), og = *(const u32x4*)(OG + off), zz = *(const u32x4*)(Zb + off);
        float x[8]; float s = 0.f;
#pragma unroll
        for (int e = 0; e < 4; ++e) {
            x[2 * e] = (bflo(hf[e]) + bflo(hb[e])) * sigmoid_f(bflo(og[e]));
            x[2 * e + 1] = (bfhi(hf[e]) + bfhi(hb[e])) * sigmoid_f(bfhi(og[e]));
            s += x[2 * e] + x[2 * e + 1];
        }
        const float mu = wave_sum(s, lane) * (1.f / 512.f);
        float q = 0.f;
#pragma unroll
        for (int e = 0; e < 8; ++e) { const float d = x[e] - mu; q += d * d; }
        const float rstd = rsqrtf(wave_sum(q, lane) * (1.f / 512.f) + EPS);
        float xc[8];
        { const f32x4 b0 = *(const f32x4*)(p.c_conv_b + col), b1 = *(const f32x4*)(p.c_conv_b + col + 4);
#pragma unroll
          for (int e = 0; e < 4; ++e) { xc[e] = b0[e]; xc[4 + e] = b1[e]; } }
        const int seq_lo = t < SEQ ? 0 : SEQ, seq_hi = t < SEQ ? SEQ : TPB;
#pragma unroll
        for (int jj = 0; jj < 4; ++jj) {
            const int tt = t + jj - 2;
            if (tt >= seq_lo && tt < seq_hi) {
                const u32x4 xm = *(const u32x4*)(XM + ((size_t)(r + jj - 2)) * EI + col);
                const f32x4 w0 = *(const f32x4*)(p.c_conv_w + jj * EI + col), w1 = *(const f32x4*)(p.c_conv_w + jj * EI + col + 4);
#pragma unroll
                for (int e = 0; e < 4; ++e) {
                    const float lo = bflo(xm[e]), hi = bfhi(xm[e]);
                    const float wl = (2 * e < 4) ? w0[(2 * e) & 3] : w1[(2 * e) & 3], wh = (2 * e + 1 < 4) ? w0[(2 * e + 1) & 3] : w1[(2 * e + 1) & 3];
                    xc[2 * e] += wl * lo; xc[2 * e + 1] += wh * hi;
                }
            }
        }
        const f32x4 g0 = *(const f32x4*)(p.c_mhn_g + col), g1 = *(const f32x4*)(p.c_mhn_g + col + 4), k0 = *(const f32x4*)(p.c_skip + col), k1 = *(const f32x4*)(p.c_skip + col + 4);
        float y[8];
#pragma unroll
        for (int e = 0; e < 8; ++e) {
            const float gg = e < 4 ? g0[e & 3] : g1[e & 3], kk = e < 4 ? k0[e & 3] : k1[e & 3];
            const float zv = (e & 1) ? bfhi(zz[e >> 1]) : bflo(zz[e >> 1]);
            y[e] = ((x[e] - mu) * rstd * gg + kk * silu_f(xc[e])) * silu_f(zv);
        }
        u32x4 o; o[0] = pack2(y[0], y[1]); o[1] = pack2(y[2], y[3]); o[2] = pack2(y[4], y[5]); o[3] = pack2(y[6], y[7]);
        *(u32x4*)(HF + off) = o;
    }
}

struct EpiBf16Split {
    bf16_t* o0; bf16_t* o1; int split; int ld;
    DI void operator()(int row, int col, f32x4 v) const {
        bf16_t* o = col < split ? o0 + col : o1 + (col - split);
        u32x2 r; r[0] = pack2(v[0], v[1]); r[1] = pack2(v[2], v[3]); *(u32x2*)(o + (size_t)row * ld) = r;
    }
};

template <int KIND>
__device__ __forceinline__ void run_phase(const Params& p, int ph, char* lds) {
    const int tid_opaque = launder((int)__builtin_amdgcn_workitem_id_x()), bid_opaque = launder_s((int)__builtin_amdgcn_workgroup_id_x());
    const int code = p.prog[ph], kind = KIND >= 0 ? KIND : (code & 0xff), layer = (code >> 8) & 0xff, g = (code >> 16) & 0xff;
    const int type = layer % 3, j = layer / 3;
    const bf16_t* ug = p.u + (size_t)g * GT * DM;
    switch (kind) {
    case PH_MOD: phase_mod(tid_opaque, bid_opaque, p, lds); break;
    case PH_PREP: {
        phase_norm(tid_opaque, bid_opaque, p, layer);
        const float* wi = type == 0 ? p.a_w_in + (size_t)j * DM * 4 * EI : type == 1 ? p.b_w_in : p.c_w_in;
        const float* wo = type == 0 ? p.a_w_out + (size_t)j * EI * DM : type == 1 ? p.b_w_out : p.c_w_out;
        phase_wconv(tid_opaque, bid_opaque, wi, p.win, DM, type == 2 ? 3 * EI : 4 * EI, lds);
        phase_wconv(tid_opaque, bid_opaque, wo, p.wout, EI, DM, lds);
    } break;
    case PH_AB_INPROJ: {
        gemm_bt(tid_opaque, bid_opaque, ug, p.win, GT, 2 * EI, DM, EpiBf16Split{p.buf[0], p.buf[1], EI, EI}, lds);
        gemm_bt(tid_opaque, bid_opaque, ug, p.win + (size_t)3 * EI * DM, GT, EI, DM, EpiBf16{p.buf[3], EI, 1.f}, lds);
        gemm_bt(tid_opaque, bid_opaque, p.win + (size_t)2 * EI * DM, ug, EI, GT, DM, EpiBf16{p.buf[2], GT, 1.f}, lds);
    } break;
    case PH_AB_QKNORM:
        if (type == 0) phase_qknorm(tid_opaque, bid_opaque, p, p.buf[0], p.buf[1], p.a_qn_g + j * 64, p.a_kn_g + j * 64, 1);
        else phase_qknorm(tid_opaque, bid_opaque, p, p.buf[0], p.buf[1], p.b_qn_g, p.b_kn_g, 0);
        break;
    case PH_A_ATTN: phase_attn_a(tid_opaque, bid_opaque, p, layer, j, layer < 3, lds); break;
    case PH_B_ATTN: phase_attn_b(tid_opaque, bid_opaque, p, 1); break;
    case PH_OUTPROJ: gemm_bt(tid_opaque, bid_opaque, type == 2 ? p.buf[3] : p.buf[0], p.wout, GT, DM, EI, EpiResid{&p, layer, g * GT, layer == 3}, lds); break;
    case PH_C_INPROJ: gemm_bt(tid_opaque, bid_opaque, ug, p.win, GT, EI, DM, EpiBf16{p.buf[0], EI, 1.f}, lds); break;
    case PH_C_PRE: phase_c_pre(tid_opaque, bid_opaque, p, lds); break;
    case PH_C_SCAN: phase_c_scan(tid_opaque, bid_opaque, p, lds); break;
    case PH_C_ZOG: gemm_bt(tid_opaque, bid_opaque, ug, p.win + (size_t)EI * DM, GT, 2 * EI, DM, EpiBf16Split{p.buf[1], p.buf[2], EI, EI}, lds); break;
    case PH_C_FINISH: phase_c_finish(tid_opaque, bid_opaque, p); break;
    default: break;
    }
}

#ifdef MK_ONE_LAUNCH
__global__ void __launch_bounds__(NTHREADS) mk_fwd(Params p, int ph_lo, int ph_hi, int use_sync) {
    extern __shared__ __attribute__((aligned(16))) char lds[];
    for (int ph = ph_lo; ph < ph_hi; ++ph) {
        run_phase<-1>(p, ph, lds);
        if (use_sync && ph + 1 < ph_hi) cg::this_grid().sync();
    }
}
#endif
template <int KIND>
__global__ void __launch_bounds__(NTHREADS) mk_one(Params p, int ph) {
    extern __shared__ __attribute__((aligned(16))) char lds[];
    run_phase<KIND>(p, ph, lds);
}
typedef void (*phase_kernel_t)(Params, int);
static phase_kernel_t phase_kernel(int kind) {
    switch (kind) {
    case PH_MOD: return mk_one<PH_MOD>; case PH_PREP: return mk_one<PH_PREP>; case PH_AB_INPROJ: return mk_one<PH_AB_INPROJ>; case PH_AB_QKNORM: return mk_one<PH_AB_QKNORM>;
    case PH_A_ATTN: return mk_one<PH_A_ATTN>; case PH_B_ATTN: return mk_one<PH_B_ATTN>; case PH_OUTPROJ: return mk_one<PH_OUTPROJ>; case PH_C_INPROJ: return mk_one<PH_C_INPROJ>;
    case PH_C_PRE: return mk_one<PH_C_PRE>; case PH_C_SCAN: return mk_one<PH_C_SCAN>; case PH_C_ZOG: return mk_one<PH_C_ZOG>; default: return mk_one<PH_C_FINISH>;
    }
}

static size_t align_up(size_t v, size_t a) { return (v + a - 1) / a * a; }

extern "C" void kernel_launch(void* const* d_in, const int* in_sizes, int n_in, void* d_out, int out_size, void* d_ws, size_t ws_size, hipStream_t stream) {
    static int grid = 0;
    Params p{};
    if (n_in != 29) { fprintf(stderr, "kernel_launch: expected 29 inputs, got %d\n", n_in); return; }
    const float** ip = (const float**)&p.x;
    for (int i = 0; i < 29; ++i) ip[i] = (const float*)d_in[i];
    p.out = (float*)d_out;
    char* ws = (char*)d_ws; size_t off = 4096;
    p.mod = (float*)(ws + off); off = align_up(off + (size_t)4 * 9 * 3072 * 4, 256);
    p.hctx = (float*)(ws + off); off = align_up(off + (size_t)NBATCH * CTXL * DM * 4, 256);
    p.win = (bf16_t*)(ws + off); off = align_up(off + (size_t)4 * EI * DM * 2, 256);
    p.wout = (bf16_t*)(ws + off); off = align_up(off + (size_t)DM * EI * 2, 256);
    p.u = (bf16_t*)(ws + off); off = align_up(off + (size_t)NTOK * DM * 2, 256);
    for (int i = 0; i < 5; ++i) { p.buf[i] = (bf16_t*)(ws + off); off = align_up(off + BUFE * 2, 256); }
    p.sbuf = (float*)(ws + off); off = align_up(off + (size_t)GB * 4 * NCHUNK * 4096 * 4, 256);
    p.gates = (float*)(ws + off); off = align_up(off + (size_t)GT * 64 * 4, 256);
    if (off > ws_size) { fprintf(stderr, "kernel_launch: workspace too small: need %zu have %zu\n", off, ws_size); return; }
    int n = 0;
    auto add = [&](int kind, int layer, int g) { p.prog[n++] = kind | (layer << 8) | (g << 16); };
    add(PH_MOD, 0, 0);
    for (int layer = 0; layer < 4; ++layer) {
        const int type = layer % 3;
        add(PH_PREP, layer, 0);
        for (int g = 0; g < NGROUP; ++g) {
            if (type == 2) { add(PH_C_INPROJ, layer, g); add(PH_C_PRE, layer, g); add(PH_C_SCAN, layer, g); add(PH_C_ZOG, layer, g); add(PH_C_FINISH, layer, g); }
            else { add(PH_AB_INPROJ, layer, g); add(PH_AB_QKNORM, layer, g); add(type == 0 ? PH_A_ATTN : PH_B_ATTN, layer, g); }
            add(PH_OUTPROJ, layer, g);
        }
    }
    p.nphases = n;
    if (grid == 0) {
        for (int k = 0; k <= PH_C_FINISH; ++k)
            if (hipFuncSetAttribute((const void*)phase_kernel(k), hipFuncAttributeMaxDynamicSharedMemorySize, LDS_BYTES) != hipSuccess) { fprintf(stderr, "kernel_launch: hipFuncSetAttribute failed\n"); grid = -1; return; }
        int dev = 0, cus = 0;
        if (hipGetDevice(&dev) != hipSuccess || hipDeviceGetAttribute(&cus, hipDeviceAttributeMultiprocessorCount, dev) != hipSuccess || cus <= 0) cus = 256;
        grid = cus;
    }
    if (grid < 0) return;
    for (int ph = 0; ph < p.nphases && ph < PH_LIMIT; ++ph)
        hipLaunchKernelGGL(phase_kernel(p.prog[ph] & 0xff), dim3(grid), dim3(NTHREADS), LDS_BYTES, stream, p, ph);
}
```

```cpp
#include <hip/hip_runtime.h>
#include <hip/hip_cooperative_groups.h>
#include <stdint.h>
#include <stdio.h>
namespace cg = cooperative_groups;

typedef unsigned short bf16_t;
typedef short bf16x8 __attribute__((ext_vector_type(8)));
typedef short bf16x4 __attribute__((ext_vector_type(4)));
typedef float f32x2 __attribute__((ext_vector_type(2)));
typedef float f32x4 __attribute__((ext_vector_type(4)));
typedef float f32x16 __attribute__((ext_vector_type(16)));
typedef __bf16 bf16x2v __attribute__((ext_vector_type(2)));
typedef unsigned u32x2 __attribute__((ext_vector_type(2)));
typedef unsigned u32x4 __attribute__((ext_vector_type(4)));

#define DI __device__ __forceinline__
#define MFMA32(a, b, c) __builtin_amdgcn_mfma_f32_32x32x16_bf16((a), (b), (c), 0, 0, 0)
#define MFMA16(a, b, c) __builtin_amdgcn_mfma_f32_16x16x32_bf16((a), (b), (c), 0, 0, 0)

constexpr int DM = 1024;
constexpr int EI = 2048;
constexpr int NBATCH = 8;
constexpr int SEQ = 2048;
constexpr int CTXL = 256;
constexpr int TPB = SEQ + CTXL;
constexpr int NTOK = NBATCH * TPB;
constexpr int GB = 4;
constexpr int GT = GB * TPB;
constexpr int NGROUP = NBATCH / GB;
constexpr float EPS = 1e-6f;
constexpr int NTHREADS = 512;
constexpr size_t BUFE = (size_t)GT * EI;
constexpr int NCHUNK = TPB / 64;
constexpr int LDS_BYTES = 160 * 1024;

enum { PH_MOD = 0, PH_PREP, PH_AB_INPROJ, PH_AB_QKNORM, PH_A_ATTN, PH_B_ATTN, PH_OUTPROJ, PH_C_INPROJ, PH_C_PRE, PH_C_SCAN, PH_C_ZOG, PH_C_FINISH, PH_NORM, PH_WCONV };
constexpr int MAX_PHASES = 64;
#ifndef PH_LIMIT
#define PH_LIMIT 1000
#endif

struct Params {
    const float *x, *c, *ctx, *c_ctx, *mod_w, *mod_b, *norm_g;
    const float *a_w_in, *a_w_out, *a_qn_g, *a_kn_g, *a_lam, *a_subln_g;
    const float *b_w_in, *b_w_out, *b_qn_g, *b_kn_g, *b_rpb;
    const float *c_w_in, *c_conv_w, *c_conv_b, *c_wq, *c_wk, *c_wv, *c_gate_w, *c_gate_b, *c_mhn_g, *c_skip, *c_w_out;
    unsigned* bar;
    float* out;
    float* mod;
    float* hctx;
    bf16_t* win; bf16_t* win2;
    bf16_t* wout;
    bf16_t* u;
    bf16_t* buf[5];
    float* sbuf;
    float* gates;
    bf16_t* gwt;
    int nphases;
    int pad_;
    long long pad2_;
    int prog[MAX_PHASES];
};


template <class T> __device__ __forceinline__ T karg(int off) { asm volatile("" : "+s"(off)); return *(const T*)((const char*)__builtin_amdgcn_kernarg_segment_ptr() + off); }
#define PF(name) karg<decltype(Params::name)>((int)__builtin_offsetof(Params, name))
#define PBUF(i) karg<bf16_t*>((int)__builtin_offsetof(Params, buf) + 8 * (i))
#define PPROG(i) karg<int>((int)__builtin_offsetof(Params, prog) + 4 * (i))
#define PHASE_IDS int lane_v_; asm volatile("s_nop 7\n\ts_nop 7\n\ts_nop 7\n\tv_mbcnt_lo_u32_b32 %0, -1, 0\n\tv_mbcnt_hi_u32_b32 %0, -1, %0" : "=v"(lane_v_)); const int tid_opaque = wid_s * 64 + lane_v_
DI int fresh_lane() { int l; asm volatile("s_nop 7\n\ts_nop 7\n\ts_nop 7\n\tv_mbcnt_lo_u32_b32 %0, -1, 0\n\tv_mbcnt_hi_u32_b32 %0, -1, %0" : "=v"(l)); return l; }
#define FRESH_TID() (wid_s * 64 + fresh_lane())
#define TIDX (tid_opaque)
#define BIDX (bid_opaque)
DI unsigned pack2(float lo, float hi) { f32x2 v = {lo, hi}; bf16x2v b = __builtin_convertvector(v, bf16x2v); return __builtin_bit_cast(unsigned, b); }
DI bf16_t f2bf(float x) { return (bf16_t)(pack2(x, 0.f) & 0xffffu); }
DI float bf2f(bf16_t v) { return __uint_as_float(((unsigned)v) << 16); }
DI float bflo(unsigned w) { return __uint_as_float(w << 16); }
DI float bfhi(unsigned w) { return __uint_as_float(w & 0xffff0000u); }
DI float shx(float v, int o, int lane) { return __uint_as_float((unsigned)__builtin_amdgcn_ds_bpermute((lane ^ o) << 2, (int)__float_as_uint(v))); }
DI float shl_from(float v, int src_lane) { return __uint_as_float((unsigned)__builtin_amdgcn_ds_bpermute((src_lane & 63) << 2, (int)__float_as_uint(v))); }
DI float wave_sum(float v, int lane) {
#pragma unroll
    for (int o = 32; o; o >>= 1) v += shx(v, o, lane);
    return v;
}
DI float wave_max(float v, int lane) {
#pragma unroll
    for (int o = 32; o; o >>= 1) v = fmaxf(v, shx(v, o, lane));
    return v;
}
DI float silu_f(float x) { return x / (1.f + __expf(-x)); }
DI float sigmoid_f(float x) { return 1.f / (1.f + __expf(-x)); }
DI bf16x8 pack_acc(const f32x16& x, int s) {
    u32x4 p;
    p[0] = pack2(x[8 * s + 0], x[8 * s + 1]); p[1] = pack2(x[8 * s + 2], x[8 * s + 3]);
    p[2] = pack2(x[8 * s + 4], x[8 * s + 5]); p[3] = pack2(x[8 * s + 6], x[8 * s + 7]);
    return __builtin_bit_cast(bf16x8, p);
}
DI bf16x8 cat4(bf16x4 lo, bf16x4 hi) { bf16x8 r; r[0] = lo[0]; r[1] = lo[1]; r[2] = lo[2]; r[3] = lo[3]; r[4] = hi[0]; r[5] = hi[1]; r[6] = hi[2]; r[7] = hi[3]; return r; }
DI int launder(int x) { asm volatile("" : "+v"(x)); return x; }
DI int launder_s(int x) { asm volatile("" : "+s"(x)); return x; }
DI void mfma_c_pad(f32x16& x) { asm volatile("s_nop 15" : "+v"(x)); }
DI int xcd_unit(int base, int bid) { return base + (bid & 7) * 32 + (bid >> 3); }
DI f32x16 zero16() { f32x16 z; for (int i = 0; i < 16; ++i) z[i] = 0.f; return z; }

struct ResidPtrs { const float* src_lat; const float* src_ctx; float* out; float* hctx; const float* mod; };
DI ResidPtrs resid_ptrs(int layer_src_is_input) { ResidPtrs r; r.out = PF(out); r.hctx = PF(hctx); r.mod = PF(mod); r.src_lat = layer_src_is_input ? PF(x) : (const float*)r.out; r.src_ctx = layer_src_is_input ? PF(ctx) : (const float*)r.hctx; return r; }
DI const float* resid_ptr(const ResidPtrs& rp, int R, int& v) {
    const int b = R / TPB, t = R - b * TPB;
    if (t < SEQ) { v = b; return rp.src_lat + ((size_t)b * SEQ + t) * DM; }
    v = 8; return rp.src_ctx + ((size_t)b * CTXL + (t - SEQ)) * DM;
}

__device__ void phase_mod(int wid_s, int bid_opaque, const Params& p, char* ldsc) {
    PHASE_IDS;
    const auto c_k = PF(c);
    const auto c_ctx_k = PF(c_ctx);
    const auto mod_k = PF(mod);
    const auto mod_b_k = PF(mod_b);
    const auto mod_w_k = PF(mod_w);
    float* sc = (float*)ldsc;
    float* red = sc + 9 * 1024;
    const int tid = TIDX, lane = tid & 63, w = tid >> 6;
    for (int i = tid; i < 9 * 1024; i += NTHREADS) { const int v = i >> 10, k = i & 1023; const float cv = v < 8 ? c_k[v * 1024 + k] : c_ctx_k[k]; sc[i] = silu_f(cv); }
    __syncthreads();
    for (int unit = BIDX; unit < 4 * 64; unit += gridDim.x) {
        const int l = unit >> 6, n0 = (unit & 63) * 48;
        const int cl = lane < 48 ? lane : 47;
        float acc[9];
#pragma unroll
        for (int v = 0; v < 9; ++v) acc[v] = 0.f;
        const float* wp = mod_w_k + (size_t)l * 1024 * 3072 + n0 + cl;
        for (int k0 = w; k0 < 1024; k0 += 128) {
            float wv[16];
#pragma unroll
            for (int j = 0; j < 16; ++j) wv[j] = wp[(size_t)(k0 + 8 * j) * 3072];
#pragma unroll
            for (int j = 0; j < 16; ++j)
#pragma unroll
                for (int v = 0; v < 9; ++v) acc[v] += sc[v * 1024 + k0 + 8 * j] * wv[j];
        }
#pragma unroll
        for (int v = 0; v < 9; ++v) red[(w * 9 + v) * 64 + lane] = acc[v];
        __syncthreads();
        for (int i = tid; i < 9 * 64; i += NTHREADS) {
            const int v = i >> 6, col = i & 63; float s = 0.f;
#pragma unroll
            for (int ww = 0; ww < 8; ++ww) s += red[(ww * 9 + v) * 64 + col];
            if (col < 48) mod_k[(l * 9 + v) * 3072 + n0 + col] = s + mod_b_k[l * 3072 + n0 + col];
        }
        __syncthreads();
    }
}

__device__ void phase_norm(int wid_s, int bid_opaque, const Params& p, int layer, int g_, int cu_lo = 0) {
    PHASE_IDS;
    const int tid = TIDX, lane = tid & 63;
    if (BIDX < cu_lo) return;
    const int gw = (BIDX - cu_lo) * 8 + (tid >> 6), nw = ((int)gridDim.x - cu_lo) * 8;
    const float* g = PF(norm_g) + layer * DM;
    const ResidPtrs rp = resid_ptrs(layer == 0);
    bf16_t* const u_ = PF(u);
    f32x4 gg[4], sh[4], scl[4];
#pragma unroll
    for (int i = 0; i < 4; ++i) gg[i] = *(const f32x4*)(g + i * 256 + lane * 4);
    for (int blk = gw >> 1; blk < GT / 9; blk += nw >> 1) {
        const int r_lo = g_ * GT + blk * 9 + (gw & 1) * 5, nr = (gw & 1) ? 4 : 5;
        int vcur = -1;
        for (int k = 0; k < nr; ++k) {
            const int R = r_lo + k;
            int v; const float* src = resid_ptr(rp, R, v);
            f32x4 xv[4]; float ss = 0.f;
#pragma unroll
            for (int i = 0; i < 4; ++i) { xv[i] = *(const f32x4*)(src + i * 256 + lane * 4); ss += xv[i][0] * xv[i][0] + xv[i][1] * xv[i][1] + xv[i][2] * xv[i][2] + xv[i][3] * xv[i][3]; }
            if (v != vcur) {
                vcur = v;
                const float* mv = rp.mod + (layer * 9 + v) * 3072;
#pragma unroll
                for (int i = 0; i < 4; ++i) { sh[i] = *(const f32x4*)(mv + i * 256 + lane * 4); scl[i] = *(const f32x4*)(mv + 1024 + i * 256 + lane * 4); }
            }
            ss = wave_sum(ss, lane);
            const float rstd = rsqrtf(ss * (1.f / DM) + EPS);
#pragma unroll
            for (int i = 0; i < 4; ++i) {
                const int col = i * 256 + lane * 4;
                f32x4 y;
#pragma unroll
                for (int e = 0; e < 4; ++e) y[e] = xv[i][e] * rstd * gg[i][e] * (1.f + scl[i][e]) + sh[i][e];
                u32x2 o; o[0] = pack2(y[0], y[1]); o[1] = pack2(y[2], y[3]);
                *(u32x2*)(u_ + (size_t)R * DM + col) = o;
            }
        }
    }
}

__device__ void phase_wconv(int wid_s, int bid_opaque, const float* W, bf16_t* Wt, int K, int N, char* ldsc, int cu_lo = 0, int permk = 0) {
    PHASE_IDS;
    if (BIDX < cu_lo) return;
    const int tid = TIDX;
    const int tilesN = N / 64, tiles = (K / 64) * tilesN, G = (int)gridDim.x - cu_lo;
    const int nn = (tid & 15) * 4;
    f32x4 v[2];
    int unit = BIDX - cu_lo;
    if (unit < tiles) {
        const int k0 = (unit / tilesN) * 64, n0 = (unit % tilesN) * 64;
#pragma unroll
        for (int hh = 0; hh < 2; ++hh) v[hh] = *(const f32x4*)(W + (size_t)(k0 + (tid >> 4) + 32 * hh) * N + n0 + nn);
    }
    for (int par = 0; unit < tiles; unit += G, par ^= 1) {
        bf16_t* t = (bf16_t*)ldsc + par * (64 * 72);
        const int k0 = (unit / tilesN) * 64, n0 = (unit % tilesN) * 64;
#pragma unroll
        for (int hh = 0; hh < 2; ++hh) {
            const int kk = ((tid >> 4) + 32 * hh + 8 * (tid & 15)) & 63;
            t[(nn + 0) * 72 + kk] = f2bf(v[hh][0]); t[(nn + 1) * 72 + kk] = f2bf(v[hh][1]); t[(nn + 2) * 72 + kk] = f2bf(v[hh][2]); t[(nn + 3) * 72 + kk] = f2bf(v[hh][3]);
        }
        if (unit + G < tiles) {
            const int un = unit + G, k1 = (un / tilesN) * 64, n1 = (un % tilesN) * 64;
#pragma unroll
            for (int hh = 0; hh < 2; ++hh) v[hh] = *(const f32x4*)(W + (size_t)(k1 + (tid >> 4) + 32 * hh) * N + n1 + nn);
        }
        __syncthreads();
        { const int n = tid >> 3, k8 = (tid & 7) * 8; int nr = n0 + n;
          if (permk && nr >= EI && nr < 2 * EI) { const int cl = nr & 255; nr = (nr & ~255) + ((cl >> 5) & 1) * 128 + (cl >> 6) * 32 + (cl & 31); }
          *(u32x4*)(Wt + (size_t)nr * K + k0 + k8) = *(const u32x4*)(t + n * 72 + ((k8 + 8 * (n >> 2)) & 63)); }
    }
    __syncthreads();
}

template <class Epi>
__device__ void gemm_bt(int wid_s, int bid_opaque, const bf16_t* A, const bf16_t* Bt, int M, int N, int K, const Epi& epi, char* lds) {
    PHASE_IDS;
    constexpr int RS = 144;
    constexpr int TB = 128 * RS;
    const int tid = TIDX, lane = tid & 63, w = tid >> 6, wm = w >> 1, wn = w & 1;
    const int ldrow = tid >> 2, ldc = (tid & 3) * 2;
    const int tilesN = N / 128, nunits = (M / 128) * tilesN, nk = K / 64;
    for (int unit = BIDX; unit < nunits; unit += gridDim.x) {
        const int m0 = (unit / tilesN) * 128, n0 = (unit % tilesN) * 128;
        const bf16_t* ga = A + (size_t)(m0 + ldrow) * K + ldc * 8;
        const bf16_t* gb = Bt + (size_t)(n0 + ldrow) * K + ldc * 8;
        f32x4 acc[2][4];
#pragma unroll
        for (int i = 0; i < 2; ++i)
#pragma unroll
            for (int j = 0; j < 4; ++j) acc[i][j] = (f32x4){0.f, 0.f, 0.f, 0.f};
        u32x4 ra0 = *(const u32x4*)ga, ra1 = *(const u32x4*)(ga + 8), rb0 = *(const u32x4*)gb, rb1 = *(const u32x4*)(gb + 8);
        {
            char* sa = lds + ldrow * RS + ldc * 16; char* sb = lds + TB + ldrow * RS + ldc * 16;
            *(u32x4*)sa = ra0; *(u32x4*)(sa + 16) = ra1; *(u32x4*)sb = rb0; *(u32x4*)(sb + 16) = rb1;
        }
        __syncthreads();
        for (int kt = 0; kt < nk; ++kt) {
            const int cur = kt & 1;
            if (kt + 1 < nk) { const bf16_t* a2 = ga + (kt + 1) * 64; const bf16_t* b2 = gb + (kt + 1) * 64; ra0 = *(const u32x4*)a2; ra1 = *(const u32x4*)(a2 + 8); rb0 = *(const u32x4*)b2; rb1 = *(const u32x4*)(b2 + 8); }
            const char* sA = lds + cur * 2 * TB; const char* sB = sA + TB;
#pragma unroll
            for (int ks = 0; ks < 2; ++ks) {
                bf16x8 af[2], bfr[4];
#pragma unroll
                for (int mt = 0; mt < 2; ++mt) af[mt] = *(const bf16x8*)(sA + (wm * 32 + mt * 16 + (lane & 15)) * RS + ks * 64 + (lane >> 4) * 16);
#pragma unroll
                for (int nt = 0; nt < 4; ++nt) bfr[nt] = *(const bf16x8*)(sB + (wn * 64 + nt * 16 + (lane & 15)) * RS + ks * 64 + (lane >> 4) * 16);
#pragma unroll
                for (int mt = 0; mt < 2; ++mt)
#pragma unroll
                    for (int nt = 0; nt < 4; ++nt) acc[mt][nt] = MFMA16(bfr[nt], af[mt], acc[mt][nt]);
            }
            if (kt + 1 < nk) {
                char* sa = lds + (cur ^ 1) * 2 * TB + ldrow * RS + ldc * 16; char* sb = sa + TB;
                *(u32x4*)sa = ra0; *(u32x4*)(sa + 16) = ra1; *(u32x4*)sb = rb0; *(u32x4*)(sb + 16) = rb1;
            }
            __syncthreads();
        }
#pragma unroll
        for (int mt = 0; mt < 2; ++mt)
#pragma unroll
            for (int nt = 0; nt < 4; ++nt) epi(m0 + wm * 32 + mt * 16 + (lane & 15), n0 + wn * 64 + nt * 16 + (lane >> 4) * 4, acc[mt][nt]);
    }
}

namespace pg8 {
#define PG8_LAS __attribute__((address_space(3)))
typedef unsigned short bf16_t;
typedef short bf16x8 __attribute__((ext_vector_type(8)));
typedef float f32x4 __attribute__((ext_vector_type(4)));
typedef unsigned u32x4 __attribute__((ext_vector_type(4)));
constexpr int BM = 256, BK = 64, HALF = 128, HTB = HALF * BK * 2  , STAGE_BYTES = 8 * HTB, NXCD = 8, WGM = 8;

__host__ __device__ __forceinline__ int lds_byte(int r, int c) { const int st = (r >> 4) * 2 + (c >> 5), rr = r & 15, cc = c & 31, ob = rr * 64 + cc * 2; return st * 1024 + (ob ^ (((ob >> 9) & 1) << 5)); }
__host__ __device__ __forceinline__ void stage_rc(int b, int& R, int& C) { const int st = b / 1024, sb = b % 1024, swz = sb ^ (((sb >> 9) & 1) << 5); R = (st >> 1) * 16 + swz / 64; C = (st & 1) * 32 + (swz % 64) / 2; }
__host__ __device__ __forceinline__ int perm32(int rho) { const int n = rho >> 4, i = rho & 15; return 8 * (i >> 2) + 4 * n + (i & 3); }

struct Unit { int pm, pn; };
struct Gemm { const bf16_t* A; const bf16_t* Bt; int M, N, K; };

struct StaticOrder {
    int nM, nN, nwg, G, c, c0 = 0, skipctx = 0;
    __host__ __device__ void init(int M, int N, int G_, int c_, int c0_ = 0) { nM = M / BM; nN = N / BM; nwg = nM * nN; G = G_; c = c_; c0 = c0_; }
    __host__ __device__ bool next(int i, Unit& u) const {
        const int nfull = nwg / G;
        long L;
        if (c0 == 0 || i < nfull) L = (long)i * G + c;
        else { if (c < c0) return false; L = (long)nfull * G + (c - c0) + (long)(G - c0) * (i - nfull); }
        if (L >= nwg) return false;
        int wgid = (int)L; { const int q = nwg / NXCD, r = nwg % NXCD, xcd = wgid % NXCD, off = wgid / NXCD; wgid = (xcd < r ? xcd * (q + 1) : r * (q + 1) + (xcd - r) * q) + off; }
        const int nig = WGM * nN, gid = wgid / nig, fm = gid * WGM, gsz = (nM - fm) < WGM ? (nM - fm) : WGM;
        u.pm = fm + ((wgid % nig) % gsz); u.pn = (wgid % nig) / gsz; if (skipctx) u.pm += u.pm >> 3; return true;
    }
    __device__ __forceinline__ void a_ready(const Unit&) const {}
    __device__ __forceinline__ void done(const Unit&) const {}
};

__device__ __forceinline__ unsigned cvt_pk_bf16(float lo, float hi) { unsigned r; asm volatile("v_cvt_pk_bf16_f32 %0, %1, %2" : "=v"(r) : "v"(lo), "v"(hi)); return r; }
typedef float f32x2 __attribute__((ext_vector_type(2)));
template <class Epi, class Sched, bool ALIGN_EPI = false, bool SP2 = false>
__device__ __forceinline__ void gemm_phase(PG8_LAS unsigned char* lds, const Gemm g, const Sched& S, const Epi& E, const int tid, const int wid) {
    const int lane = tid & 63, wr = wid >> 2, wc = wid & 3, fr = lane & 15, fq = lane >> 4;
    const int K = g.K, nt = K / BK;
    unsigned voffA[2], voffB[2];
#pragma unroll
    for (int i = 0; i < 2; ++i) { int R, C; stage_rc(tid * 16 + i * 8192, R, C); const int Rb = Epi::PERM ? ((R & ~31) + perm32(R & 31)) : R;
        voffA[i] = (unsigned)(R * K + C) * 2u; voffB[i] = (unsigned)(Rb * K + C) * 2u; }
    const size_t kstep = (size_t)(BK * 2);
    const size_t hstep = (size_t)HALF * K * 2;
    const size_t tstep = 2 * hstep;
    const unsigned ldsw = (unsigned)wid * 1024u;
    const int aoff = lds_byte(wr * 64 + fr, fq * 8), boff = lds_byte(wc * 32 + fr, fq * 8);
#define PG8_SA(b, h) (((b) * 2 + (h)) * HTB)
#define PG8_SB(b, h) ((4 + (b) * 2 + (h)) * HTB)
#define PG8_STAGE(bufoff, gbase, voff) do { _Pragma("unroll") for (int _i = 0; _i < 2; ++_i) \
        __builtin_amdgcn_global_load_lds((const unsigned*)((const char*)(gbase) + (voff)[_i]), (PG8_LAS unsigned*)(lds + (bufoff) + ldsw + _i * 8192), 16, 0, 0); } while (0)
#define PG8_LDA(dst, b, h) do { _Pragma("unroll") for (int m = 0; m < 4; ++m) _Pragma("unroll") for (int k = 0; k < 2; ++k) dst[m][k] = *(const PG8_LAS bf16x8*)(lds + PG8_SA(b, h) + aoff + m * 2048 + k * 1024); } while (0)
#define PG8_LDB(dst, b, h) do { _Pragma("unroll") for (int n = 0; n < 2; ++n) _Pragma("unroll") for (int k = 0; k < 2; ++k) dst[n][k] = *(const PG8_LAS bf16x8*)(lds + PG8_SB(b, h) + boff + n * 2048 + k * 1024); } while (0)
#define PG8_MMA(ai, bj, At, Bt) do { __builtin_amdgcn_s_setprio(1); _Pragma("unroll") for (int m = 0; m < 4; ++m) _Pragma("unroll") for (int n = 0; n < 2; ++n) _Pragma("unroll") for (int k = 0; k < 2; ++k) \
        acc[ai][bj][m][n] = __builtin_amdgcn_mfma_f32_16x16x32_bf16(Bt[n][k], At[m][k], acc[ai][bj][m][n], 0, 0, 0); __builtin_amdgcn_s_setprio(0); } while (0)
#define PG8_WAIT_V(n) asm volatile("s_waitcnt vmcnt(" #n ")" ::: "memory")
#define PG8_WAIT_L(n) asm volatile("s_waitcnt lgkmcnt(" #n ")" ::: "memory")
#define PG8_BAR __builtin_amdgcn_s_barrier()
#define PG8_SCHED __builtin_amdgcn_sched_barrier(0)
    Unit cur, nxt; int ui = 0;
    if (!S.next(0, cur)) return;
    f32x4 acc[2][2][4][2];
#pragma unroll
    for (int a = 0; a < 2; ++a)
#pragma unroll
        for (int b = 0; b < 2; ++b)
#pragma unroll
            for (int m = 0; m < 4; ++m)
#pragma unroll
                for (int n = 0; n < 2; ++n) acc[a][b][m][n] = (f32x4){0.f, 0.f, 0.f, 0.f};
    bf16x8 At[4][2], B0[2][2], B1[2][2];
    const char* cA = (const char*)g.A + (size_t)cur.pm * tstep; const char* cB = (const char*)g.Bt + (size_t)cur.pn * tstep;
    S.a_ready(cur);
    if constexpr (SP2) {
        PG8_STAGE(PG8_SB(0, 0), cB, voffB); PG8_STAGE(PG8_SB(0, 1), cB + hstep, voffB); PG8_STAGE(PG8_SA(0, 0), cA, voffA); PG8_STAGE(PG8_SA(0, 1), cA + hstep, voffA);
        if (wr == 1) PG8_BAR;
        PG8_WAIT_V(2); PG8_BAR;
        PG8_STAGE(PG8_SB(1, 0), cB + kstep, voffB); PG8_STAGE(PG8_SA(1, 0), cA + kstep, voffA); PG8_STAGE(PG8_SB(1, 1), cB + hstep + kstep, voffB);
        PG8_WAIT_V(6); PG8_BAR;
    } else {
        PG8_STAGE(PG8_SB(0, 0), cB, voffB); PG8_STAGE(PG8_SA(0, 0), cA, voffA); PG8_STAGE(PG8_SB(0, 1), cB + hstep, voffB); PG8_STAGE(PG8_SA(0, 1), cA + hstep, voffA);
        if (wr == 1) PG8_BAR;
        PG8_WAIT_V(4); PG8_BAR;
        PG8_STAGE(PG8_SB(1, 0), cB + kstep, voffB); PG8_STAGE(PG8_SA(1, 0), cA + kstep, voffA); PG8_STAGE(PG8_SB(1, 1), cB + hstep + kstep, voffB);
        PG8_WAIT_V(6); PG8_BAR;
    }
    for (;;) {
        const bool has_next = S.next(ui + 1, nxt);
        const char* nA = has_next ? (const char*)g.A + (size_t)nxt.pm * tstep : cA; const char* nB = has_next ? (const char*)g.Bt + (size_t)nxt.pn * tstep : cB;
        for (int t = 0; t < nt; t += 2) {
            const bool last = (t == nt - 2);
            const char* a1 = cA + (size_t)(t + 1) * kstep;
            const char* a2 = last ? nA : cA + (size_t)(t + 2) * kstep; const char* b2 = last ? nB : cB + (size_t)(t + 2) * kstep;
            const char* a3 = a2 + kstep; const char* b3 = b2 + kstep;
            if (last && has_next) S.a_ready(nxt);
            if constexpr (SP2) {
            PG8_LDB(B0, 0, 0); PG8_LDB(B1, 0, 1); PG8_SCHED; PG8_LDA(At, 0, 0); PG8_STAGE(PG8_SA(1, 1), a1 + hstep, voffA);
            PG8_WAIT_V(8); PG8_WAIT_L(0); PG8_BAR; PG8_MMA(0, 0, At, B0); PG8_MMA(0, 1, At, B1); PG8_BAR; PG8_SCHED;
            PG8_LDA(At, 0, 1); PG8_STAGE(PG8_SB(0, 0), b2, voffB); PG8_STAGE(PG8_SB(0, 1), b2 + hstep, voffB); PG8_STAGE(PG8_SA(0, 0), a2, voffA);
            PG8_WAIT_V(8); PG8_WAIT_L(0); PG8_BAR; PG8_MMA(1, 0, At, B0); PG8_MMA(1, 1, At, B1); PG8_BAR; PG8_SCHED;
            PG8_LDB(B0, 1, 0); PG8_LDB(B1, 1, 1); PG8_SCHED; PG8_LDA(At, 1, 0); PG8_STAGE(PG8_SA(0, 1), a2 + hstep, voffA);
            PG8_WAIT_V(8); PG8_WAIT_L(0); PG8_BAR; PG8_MMA(0, 0, At, B0); PG8_MMA(0, 1, At, B1); PG8_BAR; PG8_SCHED;
            PG8_LDA(At, 1, 1); PG8_STAGE(PG8_SB(1, 0), b3, voffB); PG8_STAGE(PG8_SB(1, 1), b3 + hstep, voffB); PG8_STAGE(PG8_SA(1, 0), a3, voffA);
            PG8_WAIT_V(8); PG8_WAIT_L(0); PG8_BAR; PG8_MMA(1, 0, At, B0); PG8_MMA(1, 1, At, B1); PG8_BAR; PG8_SCHED;
            } else {
            PG8_LDB(B0, 0, 0); PG8_SCHED; PG8_LDA(At, 0, 0); PG8_STAGE(PG8_SA(1, 1), a1 + hstep, voffA);
            PG8_WAIT_L(8); PG8_BAR; PG8_WAIT_L(0); PG8_MMA(0, 0, At, B0); PG8_BAR; PG8_SCHED;
            PG8_LDB(B1, 0, 1); PG8_STAGE(PG8_SB(0, 0), b2, voffB);
            PG8_BAR; PG8_WAIT_L(0); PG8_MMA(0, 1, At, B1); PG8_BAR;
            PG8_LDA(At, 0, 1); PG8_STAGE(PG8_SA(0, 0), a2, voffA);
            PG8_BAR; PG8_WAIT_L(0); PG8_MMA(1, 0, At, B0); PG8_BAR; PG8_SCHED;
            PG8_STAGE(PG8_SB(0, 1), b2 + hstep, voffB);
            PG8_WAIT_V(6); PG8_BAR; PG8_MMA(1, 1, At, B1); PG8_BAR;
            PG8_LDB(B0, 1, 0); PG8_SCHED; PG8_LDA(At, 1, 0); PG8_STAGE(PG8_SA(0, 1), a2 + hstep, voffA);
            PG8_WAIT_L(8); PG8_BAR; PG8_WAIT_L(0); PG8_MMA(0, 0, At, B0); PG8_BAR; PG8_SCHED;
            PG8_LDB(B1, 1, 1); PG8_STAGE(PG8_SB(1, 0), b3, voffB);
            PG8_BAR; PG8_WAIT_L(0); PG8_MMA(0, 1, At, B1); PG8_BAR;
            PG8_LDA(At, 1, 1); PG8_STAGE(PG8_SA(1, 0), a3, voffA);
            PG8_BAR; PG8_WAIT_L(0); PG8_MMA(1, 0, At, B0); PG8_BAR; PG8_SCHED;
            PG8_STAGE(PG8_SB(1, 1), b3 + hstep, voffB);
            PG8_WAIT_V(6); PG8_BAR; PG8_MMA(1, 1, At, B1); PG8_BAR;
            }
        }
        if constexpr (ALIGN_EPI) { if (wr == 0) PG8_BAR; }
        if constexpr (!Epi::AFTER_DRAIN) { E(acc, cur, wr, wc, fr, fq); S.done(cur); }
        if (!has_next) break;
#pragma unroll
        for (int a = 0; a < 2; ++a)
#pragma unroll
            for (int b = 0; b < 2; ++b)
#pragma unroll
                for (int m = 0; m < 4; ++m)
#pragma unroll
                    for (int n = 0; n < 2; ++n) acc[a][b][m][n] = (f32x4){0.f, 0.f, 0.f, 0.f};
        cur = nxt; cA = nA; cB = nB; ++ui;
        if constexpr (ALIGN_EPI) { if (wr == 1) PG8_BAR; }
    }
    PG8_WAIT_V(0);
    if constexpr (!ALIGN_EPI) { if (wr == 0) PG8_BAR; }
    PG8_BAR;
    if constexpr (Epi::AFTER_DRAIN) { E.fused(acc, cur, wr, wc, fr, fq, lds, wid, lane); S.done(cur); }
#undef PG8_SA
#undef PG8_SB
#undef PG8_STAGE
#undef PG8_LDA
#undef PG8_LDB
#undef PG8_MMA
#undef PG8_WAIT_V
#undef PG8_WAIT_L
#undef PG8_BAR
#undef PG8_SCHED
}
}

template <class F> struct EpiAdapt {
    static constexpr bool PERM = true, AFTER_DRAIN = false; F f;
    DI void operator()(const f32x4 (&acc)[2][2][4][2], const pg8::Unit& u, int wr, int wc, int fr, int fq) const {
#pragma unroll
        for (int ai = 0; ai < 2; ++ai)
#pragma unroll
            for (int m = 0; m < 4; ++m) {
                const int row = u.pm * 256 + ai * 128 + wr * 64 + m * 16 + fr;
#pragma unroll
                for (int bj = 0; bj < 2; ++bj) { const int col = u.pn * 256 + bj * 128 + wc * 32 + 8 * fq; f.store8(row, col, acc[ai][bj][m][0], acc[ai][bj][m][1]); }
            }
    }
};
template <class F>
__device__ void gemm_pg8(int wid_s, int bid_opaque, const bf16_t* A, const bf16_t* Bt, int M, int N, int K, const F& f, char* lds, int c0 = 0, int skipctx = 0) {
    PHASE_IDS;
    pg8::StaticOrder S; S.init(M, N, (int)gridDim.x, BIDX, c0); S.skipctx = skipctx;
    const pg8::Gemm g{A, Bt, M, N, K};
    pg8::gemm_phase<EpiAdapt<F>, pg8::StaticOrder, true, true>((PG8_LAS unsigned char*)lds, g, S, EpiAdapt<F>{f}, TIDX, wid_s);
}

DI void sincos_rr(float x, float& s, float& c) {
    const float n = rintf(x * 0.15915494309f);
    float r = fmaf(-n, 6.2831855f, x); r = fmaf(-n, -1.7484555e-7f, r);
    s = __sinf(r); c = __cosf(r);
}
__device__ void qknorm_own_units(int wid_s, int bid_opaque, bf16_t* Q, bf16_t* K, const float* qg, const float* kg, int rope, char* lds, int c0 = 0) {
    PHASE_IDS;
    const int tid = TIDX, lane = tid & 63, w = wid_s, half = lane & 1;
    f32x2* tab = (f32x2*)lds;
    if (rope) for (int i = tid; i < 1024; i += NTHREADS) {
        const float inv = exp2f(-(float)(i & 15) * (13.287712379549449f / 16.f));
        float s, c; sincos_rr((float)(i >> 4) * inv, s, c); tab[i] = (f32x2){c, s};
    }
    asm volatile("s_waitcnt vmcnt(0)" ::: "memory");
    __syncthreads();
    pg8::StaticOrder S; S.init(GT, 4 * EI, (int)gridDim.x, BIDX, c0);
    pg8::Unit u;
    for (int ui = 0; S.next(ui, u); ++ui) {
        if (u.pn < 8 || u.pn >= 16) continue;
        bf16_t* B = (u.pn >> 3) ? K : Q;
        const float* g = ((u.pn >> 3) ? kg : qg) + half * 32;
        const int colbase = (u.pn & 7) * 256 + ((lane >> 1) & 3) * 64 + half * 32;
        u32x4 nxt[4];
        { const bf16_t* b0 = B + (size_t)(u.pm * 256 + w * 8 + (lane >> 3)) * EI + colbase;
#pragma unroll
          for (int i = 0; i < 4; ++i) nxt[i] = *(const u32x4*)(b0 + i * 8); }
#pragma unroll
        for (int it = w; it < 32; it += 8) {
            const int r = u.pm * 256 + it * 8 + (lane >> 3);
            bf16_t* base = B + (size_t)r * EI + colbase;
            u32x4 raw[4];
#pragma unroll
            for (int i = 0; i < 4; ++i) raw[i] = nxt[i];
            if (it + 8 < 32) {
#pragma unroll
                for (int i = 0; i < 4; ++i) nxt[i] = *(const u32x4*)(base + (size_t)64 * EI + i * 8);
            }
            float y[32]; float ss = 0.f;
#pragma unroll
            for (int i = 0; i < 4; ++i)
#pragma unroll
                for (int e = 0; e < 4; ++e) { y[i * 8 + 2 * e] = bflo(raw[i][e]); y[i * 8 + 2 * e + 1] = bfhi(raw[i][e]); }
#pragma unroll
            for (int d = 0; d < 32; ++d) ss += y[d] * y[d];
            ss += shx(ss, 1, lane);
            const float rstd = rsqrtf(ss * (1.f / 64.f) + EPS);
#pragma unroll
            for (int d = 0; d < 32; ++d) y[d] = y[d] * rstd * g[d];
            const int t = r % TPB;
            if (rope && t < SEQ) {
                const f32x2* cs = tab + (half ? (t & 63) : (t >> 6)) * 16;
#pragma unroll
                for (int i = 0; i < 16; ++i) {
                    const f32x2 v = cs[i];
                    const float a_ = y[i], b_ = y[i + 16];
                    y[i] = a_ * v[0] - b_ * v[1]; y[i + 16] = b_ * v[0] + a_ * v[1];
                }
            }
#pragma unroll
            for (int i = 0; i < 4; ++i) { u32x4 o;
#pragma unroll
                for (int e = 0; e < 4; ++e) o[e] = pack2(y[i * 8 + 2 * e], y[i * 8 + 2 * e + 1]);
                *(u32x4*)(base + i * 8) = o; }
        }
    }
}

struct EpiInProj {
    static constexpr bool PERM = true, AFTER_DRAIN = false;
    bf16_t* o0; const float* kg; const f32x2* tab; int rope;
    DI void operator()(const f32x4 (&acc)[2][2][4][2], const pg8::Unit& u, int wr, int wc, int fr, int fq) const {
        if ((u.pn >> 3) != 1) {
#pragma unroll
            for (int ai = 0; ai < 2; ++ai)
#pragma unroll
                for (int m = 0; m < 4; ++m) {
                    const int row = u.pm * 256 + ai * 128 + wr * 64 + m * 16 + fr;
#pragma unroll
                    for (int bj = 0; bj < 2; ++bj) {
                        const int col = u.pn * 256 + bj * 128 + wc * 32 + 8 * fq;
                        const f32x4 a = acc[ai][bj][m][0], b = acc[ai][bj][m][1];
                        u32x4 r; r[0] = pack2(a[0], a[1]); r[1] = pack2(a[2], a[3]); r[2] = pack2(b[0], b[1]); r[3] = pack2(b[2], b[3]);
                        *(u32x4*)(o0 + (size_t)(col >> 11) * BUFE + (size_t)row * EI + (col & 2047)) = r;
                    }
                }
            return;
        }
        const int lane = fq * 16 + fr;
        const bool lat = (u.pm % 9) != 8;
        const float sgn = fq < 2 ? -1.f : 1.f;
        f32x4 g[2][2];
#pragma unroll
        for (int bj = 0; bj < 2; ++bj) { g[bj][0] = *(const f32x4*)(kg + bj * 32 + 8 * fq); g[bj][1] = *(const f32x4*)(kg + bj * 32 + 8 * fq + 4); }
        bf16_t* const kout = o0 + BUFE;
#pragma unroll
        for (int ai = 0; ai < 2; ++ai)
#pragma unroll
            for (int m = 0; m < 4; ++m) {
                const int row = u.pm * 256 + ai * 128 + wr * 64 + m * 16 + fr;
                float y[2][8]; float ss = 0.f;
#pragma unroll
                for (int bj = 0; bj < 2; ++bj)
#pragma unroll
                    for (int j = 0; j < 8; ++j) { y[bj][j] = acc[ai][bj][m][j >> 2][j & 3]; ss += y[bj][j] * y[bj][j]; }
                ss += shx(ss, 16, lane); ss += shx(ss, 32, lane);
                const float rstd = rsqrtf(ss * (1.f / 64.f) + EPS);
#pragma unroll
                for (int bj = 0; bj < 2; ++bj)
#pragma unroll
                    for (int j = 0; j < 8; ++j) y[bj][j] = y[bj][j] * rstd * g[bj][j >> 2][j & 3];
                if (rope && lat) {
                    const int t = row % TPB;
#pragma unroll
                    for (int bj = 0; bj < 2; ++bj) {
                        const f32x2* cs = tab + (bj ? (t & 63) : (t >> 6)) * 16 + 8 * (fq & 1);
#pragma unroll
                        for (int j = 0; j < 8; ++j) { const f32x2 v = cs[j]; const float other = shx(y[bj][j], 32, lane); y[bj][j] = y[bj][j] * v[0] + sgn * other * v[1]; }
                    }
                }
#pragma unroll
                for (int bj = 0; bj < 2; ++bj) {
                    const int col = (u.pn & 7) * 256 + wc * 64 + bj * 32 + 8 * fq;
                    u32x4 r; r[0] = pack2(y[bj][0], y[bj][1]); r[1] = pack2(y[bj][2], y[bj][3]); r[2] = pack2(y[bj][4], y[bj][5]); r[3] = pack2(y[bj][6], y[bj][7]);
                    *(u32x4*)(kout + (size_t)row * EI + col) = r;
                }
            }
    }
};
struct EpiBf16 {
    bf16_t* out; int ld; float scale;
    DI void operator()(int row, int col, f32x4 v) const { u32x2 o; o[0] = pack2(v[0] * scale, v[1] * scale); o[1] = pack2(v[2] * scale, v[3] * scale); *(u32x2*)(out + (size_t)row * ld + col) = o; }
    DI void store8(int row, int col, f32x4 a, f32x4 b) const { u32x4 o; o[0] = pack2(a[0] * scale, a[1] * scale); o[1] = pack2(a[2] * scale, a[3] * scale); o[2] = pack2(b[0] * scale, b[1] * scale); o[3] = pack2(b[2] * scale, b[3] * scale); *(u32x4*)(out + (size_t)row * ld + col) = o; }
};
struct EpiResid {
    ResidPtrs rp; int layer; int row_off; int lat_only;
    DI void operator()(int row, int col, f32x4 v) const {
        const int R = row_off + row; int mvi;
        const int b = R / TPB, t = R - b * TPB;
        if (lat_only && t >= SEQ) return;
        const float* src = resid_ptr(rp, R, mvi);
        float* dst = (t < SEQ) ? rp.out + ((size_t)b * SEQ + t) * DM : rp.hctx + ((size_t)b * CTXL + (t - SEQ)) * DM;
        const f32x4 g = *(const f32x4*)(rp.mod + (layer * 9 + mvi) * 3072 + 2048 + col);
        const f32x4 base = *(const f32x4*)(src + col);
        f32x4 o;
#pragma unroll
        for (int e = 0; e < 4; ++e) o[e] = base[e] + g[e] * v[e];
        *(f32x4*)(dst + col) = o;
    }
    DI void store8(int row, int col, f32x4 a, f32x4 b) const { (*this)(row, col, a); (*this)(row, col + 4, b); }
};

#define LAS __attribute__((address_space(3)))
typedef __attribute__((address_space(3))) bf16x4 lds_bf16x4;
DI bf16x4 tr_read(const char* p) { return __builtin_amdgcn_ds_read_tr16_b64_v4i16((lds_bf16x4*)p); }
DI void qnorm_frag(const u32x4 (&raw)[4], const float* gq, const f32x2* tab, int t, bool rope, float c, int lane_, bf16x8 (&qf)[4]) {
    const int h = lane_ >> 5;
    float y[4][8]; float ss = 0.f;
#pragma unroll
    for (int s = 0; s < 4; ++s)
#pragma unroll
        for (int e = 0; e < 4; ++e) { y[s][2 * e] = bflo(raw[s][e]); y[s][2 * e + 1] = bfhi(raw[s][e]); ss += y[s][2 * e] * y[s][2 * e] + y[s][2 * e + 1] * y[s][2 * e + 1]; }
    ss += shx(ss, 32, lane_);
    const float rstd = rsqrtf(ss * (1.f / 64.f) + EPS);
#pragma unroll
    for (int s = 0; s < 4; ++s) {
        const f32x4 g0 = *(const f32x4*)(gq + s * 16 + h * 8), g1 = *(const f32x4*)(gq + s * 16 + h * 8 + 4);
#pragma unroll
        for (int j = 0; j < 8; ++j) y[s][j] = y[s][j] * rstd * (j < 4 ? g0[j & 3] : g1[j & 3]);
    }
    if (rope) {
#pragma unroll
        for (int hf = 0; hf < 2; ++hf) {
            const f32x2* cs = tab + (hf ? (t & 63) : (t >> 6)) * 16 + h * 8;
#pragma unroll
            for (int j = 0; j < 8; ++j) {
                const f32x2 v = cs[j];
                const float a_ = y[2 * hf][j], b_ = y[2 * hf + 1][j];
                y[2 * hf][j] = a_ * v[0] - b_ * v[1]; y[2 * hf + 1][j] = b_ * v[0] + a_ * v[1];
            }
        }
    }
#pragma unroll
    for (int s = 0; s < 4; ++s) {
        u32x4 o;
#pragma unroll
        for (int e = 0; e < 4; ++e) o[e] = pack2(y[s][2 * e] * c, y[s][2 * e + 1] * c);
        qf[s] = __builtin_bit_cast(bf16x8, o);
    }
}
DI void rope_table(f32x2* tab, int tid) {
    for (int i = tid; i < 1024; i += NTHREADS) {
        const float inv = exp2f(-(float)(i & 15) * (13.287712379549449f / 16.f));
        float s, c; sincos_rr((float)(i >> 4) * inv, s, c); tab[i] = (f32x2){c, s};
    }
}
__device__ void phase_inproj_ab(int wid_s, int bid_opaque, const bf16_t* A, const bf16_t* Bt, bf16_t* o0, const float* kg, int rope, char* lds, int c0) {
    PHASE_IDS;
    f32x2* tab = (f32x2*)(lds + 131072);
    if (rope) rope_table(tab, TIDX);
    __syncthreads();
    pg8::StaticOrder S; S.init(GT, 4 * EI, (int)gridDim.x, BIDX, c0);
    const pg8::Gemm g{A, Bt, GT, 4 * EI, DM};
    pg8::gemm_phase<EpiInProj, pg8::StaticOrder, true, true>((PG8_LAS unsigned char*)lds, g, S, EpiInProj{o0, kg, tab, rope}, TIDX, wid_s);
}
template <bool SHIFT>
__device__ void phase_attn_a(int wid_s, int bid_opaque, const Params& p, int layer, int j, int need_ctx, char* lds) {
    PHASE_IDS;
    const int tid = TIDX, lane = tid & 63, w = wid_s, sub = w >> 2, qg = w & 3;
    const bf16_t* Q = PBUF(0); const bf16_t* Kb = PBUF(1); const bf16_t* Vb = PBUF(2); const bf16_t* Z = PBUF(3); bf16_t* Y = PBUF(4);
    const float* lv = PF(a_lam) + j * 256;
    const float d1 = wave_sum(lv[lane] * lv[64 + lane], lane), d2 = wave_sum(lv[128 + lane] * lv[192 + lane], lane);
    const float lam_init = 0.8f - 0.6f * expf(-0.3f * (float)layer);
    const float lam = expf(d1) - expf(d2) + lam_init;
    const float gqm = wave_max(fabsf(PF(a_qn_g)[j * 64 + lane]), lane), gkm = wave_max(fabsf(PF(a_kn_g)[j * 64 + lane]), lane);
    const float c1 = 0.125f * 1.4426950408889634f, c2 = 8.f * gqm * gkm * 1.4426950408889634f;
    const float* sg = PF(a_subln_g) + j * 128;
    const float* gqn = PF(a_qn_g) + j * 64;
    f32x2* rtab = (f32x2*)(lds + 132096);
    rope_table(rtab, tid);
    __syncthreads();
    const int nlat = GB * 16 * 16, nunits = nlat + (need_ctx ? GB * 16 * 2 : 0);
    for (int ubase = 0; ubase < nunits; ubase += 256) {
        const int unit = gridDim.x == 256 ? xcd_unit(ubase, BIDX) : ubase + BIDX;
        if (unit >= nunits || (gridDim.x != 256 && BIDX >= 256)) continue;
        int bl, vh, q0, kt0, nkt;
        if (unit < nlat) { bl = unit >> 8; vh = (unit >> 4) & 15; q0 = (unit & 15) * 128 + qg * 32; kt0 = 0; nkt = TPB / 128; }
        else { const int u2 = unit - nlat; bl = u2 >> 5; vh = (u2 >> 1) & 15; q0 = SEQ + (u2 & 1) * 128 + qg * 32; kt0 = SEQ / 128; nkt = CTXL / 128; }
        bf16x8 qf[4];
        {
            const int lane_ = launder(lane), li = lane_ & 31, h = lane_ >> 5;
            u32x4 raw[4];
#pragma unroll
            for (int s = 0; s < 4; ++s) raw[s] = *(const u32x4*)(Q + ((size_t)(bl * TPB + q0 + li)) * EI + vh * 128 + sub * 64 + s * 16 + h * 8);
            qnorm_frag(raw, gqn, rtab, q0 + li, q0 < SEQ, c1, lane_, qf);
        }
        const bf16_t* kgbase = Kb + ((size_t)(bl * TPB + kt0 * 128)) * EI + vh * 128;
        const bf16_t* vgbase = Vb + ((size_t)(bl * TPB + kt0 * 128)) * EI + vh * 128;
#define ATT_STAGE(buf, tile, ln) do { const int srow_ = (ln) >> 4, spos_ = (ln) & 15; const size_t to_ = (size_t)(tile) * 128 * EI; LAS char* lb_ = (LAS char*)(lds) + (buf) * 65536 + w * 4096; \
            _Pragma("unroll") for (int pc_ = 0; pc_ < 4; ++pc_) { const int r_ = 16 * w + 4 * pc_ + srow_; \
                __builtin_amdgcn_global_load_lds((const unsigned*)(kgbase + to_ + (unsigned)(r_ * EI + ((spos_ ^ (r_ & 15)) << 3))), (LAS unsigned*)(lb_ + pc_ * 1024), 16, 0, 0); \
                __builtin_amdgcn_global_load_lds((const unsigned*)(vgbase + to_ + (unsigned)(r_ * EI + ((spos_ ^ ((r_ & 3) << 2)) << 3))), (LAS unsigned*)(lb_ + 32768 + pc_ * 1024), 16, 0, 0); } } while (0)
        ATT_STAGE(0, 0, launder(lane));
        __syncthreads();
        f32x16 O[4];
#pragma unroll
        for (int d = 0; d < 4; ++d) O[d] = zero16();
        float l = 0.f;
        for (int it = 0; it < nkt; ++it) {
            const int lane_ = launder(lane), li = lane_ & 31, h = lane_ >> 5;
            const char* kvb = lds + (it & 1) * 65536;
            if (it + 1 < nkt) ATT_STAGE((it + 1) & 1, it + 1, lane_);
            const int g_ = lane_ >> 4, i_ = lane_ & 15, vq = i_ >> 2, vp = i_ & 3;
            const char* vrd = kvb + 32768 + (4 * h + vq) * 256 + (vp & 1) * 8;
            const int vch = 2 * (g_ & 1) + (vp >> 1), vsw = vq << 2, dsw = 2 * sub;
            bf16x8 kfr[2][4]; bf16x4 vt[2][4][4];
#define ATT_LOADK(set, kb_) do { const int krow_ = (kb_) * 32 + li; const char* krd_ = kvb + krow_ * 256; const int ksw_ = krow_ & 15; \
                _Pragma("unroll") for (int s = 0; s < 4; ++s) kfr[set][s] = *(const bf16x8*)(krd_ + (((8 * sub + 2 * s + h) ^ ksw_) << 4)); } while (0)
#define ATT_LOADV(set, kb_) do { _Pragma("unroll") for (int d = 0; d < 4; ++d) { const char* va_ = vrd + ((kb_) * 32) * 256 + (((4 * (d ^ dsw) + vch) ^ vsw) << 4); \
                    _Pragma("unroll") for (int q8 = 0; q8 < 4; ++q8) vt[set][d][q8] = tr_read(va_ + q8 * 8 * 256); } } while (0)
            ATT_LOADK(0, 0); ATT_LOADK(1, 1); ATT_LOADV(0, 0);
            f32x16 Sc = zero16();
#pragma unroll
            for (int s = 0; s < 4; ++s) Sc = MFMA32(kfr[0][s], qf[s], Sc);
#pragma unroll
            for (int kb = 0; kb < 4; ++kb) {
                f32x16 Sn = zero16();
                if (kb + 1 < 4) {
#pragma unroll
                    for (int s = 0; s < 4; ++s) Sn = MFMA32(kfr[(kb + 1) & 1][s], qf[s], Sn);
                }
                if (kb + 2 < 4) { if (kb & 1) ATT_LOADK(1, kb + 2); else ATT_LOADK(0, kb + 2); }
                if (kb + 1 < 4) { if (kb & 1) ATT_LOADV(0, kb + 1); else ATT_LOADV(1, kb + 1); }
                float ps = 0.f;
#pragma unroll
                for (int r = 0; r < 16; ++r) { const float e = __builtin_amdgcn_exp2f(SHIFT ? Sc[r] - c2 : Sc[r]); Sc[r] = e; ps += e; }
                l += ps;
                const bf16x8 pf0 = pack_acc(Sc, 0), pf1 = pack_acc(Sc, 1);
#pragma unroll
                for (int d = 0; d < 4; ++d) {
                    O[d] = MFMA32(cat4(vt[kb & 1][d][0], vt[kb & 1][d][1]), pf0, O[d]);
                    O[d] = MFMA32(cat4(vt[kb & 1][d][2], vt[kb & 1][d][3]), pf1, O[d]);
                }
                Sc = Sn;
            }
            __syncthreads();
        }
        const int lane_e = launder(lane), li = lane_e & 31, h = lane_e >> 5;
        float* xch = (float*)lds + qg * 4096 + lane_e * 4;
        float* ssx = (float*)lds + 4 * 4096 + qg * 64;
        l += shx(l, 32, lane_e);
        const float inv = (sub == 1 ? lam : 1.f) / l;
        const int dsw_e = 2 * sub;
#pragma unroll
        for (int dd_ = 0; dd_ < 2; ++dd_) {
            const int d = (2 + dd_) ^ dsw_e;
#pragma unroll
            for (int r4 = 0; r4 < 4; ++r4)
                *(f32x4*)(xch + (d * 4 + r4) * 256) = (f32x4){O[2 + dd_][4 * r4] * inv, O[2 + dd_][4 * r4 + 1] * inv, O[2 + dd_][4 * r4 + 2] * inv, O[2 + dd_][4 * r4 + 3] * inv};
        }
        __syncthreads();
        {
            const size_t qoff = ((size_t)(bl * TPB + q0 + li)) * EI + vh * 128;
            const float sgn = sub == 0 ? 1.f : -1.f;
            float ss = 0.f;
#pragma unroll
            for (int dd_ = 0; dd_ < 2; ++dd_) {
                const int d = dd_ ^ dsw_e;
#pragma unroll
                for (int r4 = 0; r4 < 4; ++r4) {
                    const f32x4 xo = *(const f32x4*)(xch + (d * 4 + r4) * 256);
#pragma unroll
                    for (int e = 0; e < 4; ++e) { const float o = sgn * (O[dd_][4 * r4 + e] * inv - xo[e]); O[dd_][4 * r4 + e] = o; ss += o * o; }
                }
            }
            ss += shx(ss, 32, lane_e);
            if (h == 0) ssx[sub * 32 + li] = ss;
            __syncthreads();
            ss += ssx[(sub ^ 1) * 32 + li];
            const float rs = rsqrtf(ss * (1.f / 128.f) + EPS) * (1.f - lam_init);
#pragma unroll
            for (int dd_ = 0; dd_ < 2; ++dd_) {
                const int d = dd_ ^ dsw_e;
#pragma unroll
                for (int g4 = 0; g4 < 4; ++g4) {
                    const int dd = d * 32 + 8 * g4 + 4 * h;
                    const u32x2 zr = *(const u32x2*)(Z + qoff + dd);
                    const f32x4 sgv = *(const f32x4*)(sg + dd);
                    const float z0 = bflo(zr[0]), z1 = bfhi(zr[0]), z2 = bflo(zr[1]), z3 = bfhi(zr[1]);
                    u32x2 o;
                    o[0] = pack2(O[dd_][4 * g4 + 0] * rs * sgv[0] * silu_f(z0), O[dd_][4 * g4 + 1] * rs * sgv[1] * silu_f(z1));
                    o[1] = pack2(O[dd_][4 * g4 + 2] * rs * sgv[2] * silu_f(z2), O[dd_][4 * g4 + 3] * rs * sgv[3] * silu_f(z3));
                    *(u32x2*)(Y + qoff + dd) = o;
                }
            }
        }
        __syncthreads();
    }
}

DI void glds16(const void* g, unsigned lds_base) {
    unsigned sv; asm volatile("s_mov_b32 %0, m0\n\ts_mov_b32 m0, %2\n\ts_nop 0\n\tglobal_load_lds_dwordx4 %1, off\n\ts_mov_b32 m0, %0" : "=&s"(sv) : "v"(g), "s"(lds_base) : "memory"); }
#define NAT_FENCE() asm volatile("" ::: "memory")
template <bool LAT, int QB, int KB>
DI void nat_bias(const char* brow, const unsigned (&bo4)[4], float (&bias)[16]) {
#pragma unroll
    for (int r = 0; r < 16; ++r) {
        const bool maybe = LAT && ((QB == KB) || (QB == 0 ? r < 4 : r >= 12));
        if (maybe) { unsigned b4 = bo4[r >> 2]; asm volatile("" : "+v"(b4)); bias[r] = *(const float*)(brow + ((b4 >> (8 * (r & 3))) & 0xffu)); }
        else bias[r] = 0.f;
    }
}
template <bool LAT, int QB, int KB>
DI float nat_exps(f32x16& S, const float (&bias)[16], float c2) {
    const float L2E = 1.4426950408889634f;
    float ps = 0.f;
#pragma unroll
    for (int r = 0; r < 16; ++r) {
        const bool maybe = !LAT || (QB == KB) || (QB == 0 ? r < 4 : r >= 12);
        float e = 0.f;
        if (maybe) e = __builtin_amdgcn_exp2f(S[r] * (0.125f * L2E) + (LAT ? bias[r] : -c2));
        S[r] = e; ps += e;
    }
    return ps;
}
template <bool LAT>
DI void nat_tile(const char* kvb, const char* brow, float c2, const bf16x8 (&qf)[2][4], const unsigned (&boff)[2][2][4], f32x16 (&O)[2][2], float (&l)[2], int lane_) {
    const int li = lane_ & 31, h = lane_ >> 5;
    const int g_ = lane_ >> 4, i_ = lane_ & 15, vq = i_ >> 2, vp = i_ & 3;
    const char* vrd = kvb + 8192 + (4 * h + vq) * 128 + (vp & 1) * 8;
    const int vch = 2 * (g_ & 1) + (vp >> 1), vsw = (vq >> 1) << 2;
    const char* krd0 = kvb + li * 128; const int ksw = li & 7;
    bf16x8 kf0[4], kf1[4], vt[2][2];
    float bA[16], bB[16];
    f32x16 Sa, Sb;
    bf16x8 pa[2], pb[2];
#pragma unroll
    for (int s = 0; s < 4; ++s) kf0[s] = *(const bf16x8*)(krd0 + (((2 * s + h) ^ ksw) << 4));
    nat_bias<LAT, 0, 0>(brow, boff[0][0], bA);
    NAT_FENCE();
    Sa = zero16(); Sb = zero16();
#pragma unroll
    for (int s = 0; s < 4; ++s) Sa = MFMA32(kf0[s], qf[0][s], Sa);
#pragma unroll
    for (int s = 0; s < 4; ++s) Sb = MFMA32(kf0[s], qf[1][s], Sb);
#pragma unroll
    for (int s = 0; s < 4; ++s) kf1[s] = *(const bf16x8*)(krd0 + 32 * 128 + (((2 * s + h) ^ ksw) << 4));
    nat_bias<LAT, 1, 0>(brow, boff[1][0], bB);
#pragma unroll
    for (int d = 0; d < 2; ++d)
#pragma unroll
        for (int s = 0; s < 2; ++s) { const char* va = vrd + (16 * s) * 128 + (((4 * d + vch) ^ vsw) << 4); vt[d][s] = cat4(tr_read(va), tr_read(va + 8 * 128)); }
    NAT_FENCE();
    l[0] += nat_exps<LAT, 0, 0>(Sa, bA, c2); pa[0] = pack_acc(Sa, 0); pa[1] = pack_acc(Sa, 1);
    nat_bias<LAT, 0, 1>(brow, boff[0][1], bA);
    Sa = zero16();
#pragma unroll
    for (int s = 0; s < 4; ++s) Sa = MFMA32(kf1[s], qf[0][s], Sa);
    NAT_FENCE();
    l[1] += nat_exps<LAT, 1, 0>(Sb, bB, c2); if (!LAT) pb[0] = pack_acc(Sb, 0); pb[1] = pack_acc(Sb, 1);
    nat_bias<LAT, 1, 1>(brow, boff[1][1], bB);
    Sb = zero16();
#pragma unroll
    for (int s = 0; s < 4; ++s) Sb = MFMA32(kf1[s], qf[1][s], Sb);
#pragma unroll
    for (int d = 0; d < 2; ++d) {
        O[0][d] = MFMA32(vt[d][0], pa[0], O[0][d]); O[0][d] = MFMA32(vt[d][1], pa[1], O[0][d]);
        if (!LAT) O[1][d] = MFMA32(vt[d][0], pb[0], O[1][d]);
        O[1][d] = MFMA32(vt[d][1], pb[1], O[1][d]);
    }
#pragma unroll
    for (int d = 0; d < 2; ++d)
#pragma unroll
        for (int s = 0; s < 2; ++s) { const char* va = vrd + (32 + 16 * s) * 128 + (((4 * d + vch) ^ vsw) << 4); vt[d][s] = cat4(tr_read(va), tr_read(va + 8 * 128)); }
    NAT_FENCE();
    l[0] += nat_exps<LAT, 0, 1>(Sa, bA, c2); pa[0] = pack_acc(Sa, 0); if (!LAT) pa[1] = pack_acc(Sa, 1);
    l[1] += nat_exps<LAT, 1, 1>(Sb, bB, c2); pb[0] = pack_acc(Sb, 0); pb[1] = pack_acc(Sb, 1);
#pragma unroll
    for (int d = 0; d < 2; ++d) {
        O[0][d] = MFMA32(vt[d][0], pa[0], O[0][d]);
        if (!LAT) O[0][d] = MFMA32(vt[d][1], pa[1], O[0][d]);
        O[1][d] = MFMA32(vt[d][0], pb[0], O[1][d]); O[1][d] = MFMA32(vt[d][1], pb[1], O[1][d]);
    }
}

__device__ void phase_attn_b(int wid_s, int bid_opaque, const Params& p, int need_ctx, char* lds) {
    PHASE_IDS;
    const float* const rpb_g = PF(b_rpb);
    const int tid = TIDX, lane = tid & 63, w = wid_s;
    const bf16_t* Q = PBUF(0); const bf16_t* Kb = PBUF(1); const bf16_t* Vb = PBUF(2); const bf16_t* Z = PBUF(3); bf16_t* Y = PBUF(4);
    const unsigned lbase = (unsigned)(size_t)(LAS char*)lds;
    const float gqm = wave_max(fabsf(PF(b_qn_g)[lane]), lane), gkm = wave_max(fabsf(PF(b_kn_g)[lane]), lane);
    const float L2E = 1.4426950408889634f;
    float* rpb_s = (float*)(lds + 65536);
    unsigned boff[2][2][4];
    {
        const int li = lane & 31, h = lane >> 5;
#pragma unroll
        for (int qb = 0; qb < 2; ++qb)
#pragma unroll
            for (int kb = 0; kb < 2; ++kb)
#pragma unroll
                for (int r4 = 0; r4 < 4; ++r4) {
                    unsigned pk = 0;
#pragma unroll
                    for (int e = 0; e < 4; ++e) {
                        const int r = 4 * r4 + e, qc = 32 * qb + li, ws = min(max(qc - 8, 0), 48), kc = kb * 32 + (r & 3) + 8 * (r >> 2) + 4 * h;
                        const bool valid = (kc >= ws) && (kc < ws + 16);
                        pk |= (unsigned)((valid ? (kc - qc + 15) : 31) * 4) << (8 * e);
                    }
                    boff[qb][kb][r4] = pk;
                }
    }
    const int nlat = GB * 32 * 4, nunits = nlat + (need_ctx ? GB * 32 : 0);
    for (int ubase = 0; ubase < nunits; ubase += 256) {
        const int unit = gridDim.x == 256 ? xcd_unit(ubase, BIDX) : ubase + BIDX;
        if (unit >= nunits || (gridDim.x != 256 && BIDX >= 256)) continue;
        int bl, head, rg = 0; bool isctx;
        if (unit < nlat) { bl = unit >> 7; head = (unit >> 2) & 31; rg = unit & 3; isctx = false; }
        else { const int u2 = unit - nlat; bl = u2 >> 5; head = u2 & 31; isctx = true; }
        const int row = 8 * rg + w;
        const int q0 = isctx ? SEQ + 64 * (w & 3) : row * 64;
        const int rs = min(max(row - 4, 0), 24);
        const int krlo = isctx ? 0 : min(max(8 * rg - 4, 0), 24), krhi = isctx ? -1 : min(max(8 * rg + 3, 0), 24) + 7;
        const int nlt = krhi - krlo + 1, nt = nlt + 4;
        float bm = 0.f;
        const int tid_u = launder(tid), lane_u = tid_u & 63;
        for (int i = lane_u; i < 465; i += 64) bm = fmaxf(bm, fabsf(rpb_g[head * 465 + i]));
        bm = wave_max(bm, lane_u);
        const float c2 = (8.f * gqm * gkm + bm) * L2E;
        if (tid_u < 480) { const int rr = tid_u >> 5, cc = tid_u & 31; rpb_s[tid_u] = cc < 31 ? rpb_g[head * 465 + rr * 31 + cc] * L2E - c2 : -1e30f; }
        bf16x8 qf[2][4];
        {
            const int lane_q = launder(lane), li = lane_q & 31, h = lane_q >> 5;
#pragma unroll
            for (int qb = 0; qb < 2; ++qb) {
                u32x4 raw[4];
#pragma unroll
                for (int s = 0; s < 4; ++s) raw[s] = *(const u32x4*)(Q + ((size_t)(bl * TPB + q0 + 32 * qb + li)) * EI + head * 64 + s * 16 + h * 8);
                qnorm_frag(raw, PF(b_qn_g), (const f32x2*)nullptr, 0, false, 1.f, lane_q, qf[qb]);
            }
        }
        const bf16_t* kbase = Kb + (size_t)bl * TPB * EI + head * 64;
        const bf16_t* vbase = Vb + (size_t)bl * TPB * EI + head * 64;
#define NAT_TOK(t_) ((t_) < nlt ? (krlo + (t_)) * 64 : SEQ + ((t_) - nlt) * 64)
#define NAT_ISSUE(t_) do { const int ti_ = (t_) < nt ? (t_) : nt - 1; const int ln_ = launder(lane), r_ = 8 * w + (ln_ >> 3), c_ = ln_ & 7; const size_t ro_ = (size_t)(NAT_TOK(ti_) + r_) * EI; \
            const unsigned sl_ = lbase + (unsigned)(((t_) & 3) * 16384 + w * 1024); \
            glds16(kbase + ro_ + ((c_ ^ (r_ & 7)) << 3), sl_); glds16(vbase + ro_ + ((c_ ^ (((r_ >> 1) & 1) << 2)) << 3), sl_ + 8192u); } while (0)
#pragma unroll
        for (int qb = 0; qb < 2; ++qb)
#pragma unroll
            for (int s = 0; s < 4; ++s) asm volatile("" : "+v"(qf[qb][s]));
        NAT_ISSUE(0); NAT_ISSUE(1); NAT_ISSUE(2);
        f32x16 O[2][2];
#pragma unroll
        for (int a_ = 0; a_ < 2; ++a_) { O[a_][0] = zero16(); O[a_][1] = zero16(); }
        float l[2] = {0.f, 0.f};
        for (int it = 0; it < nt; ++it) {
            asm volatile("s_waitcnt vmcnt(4) lgkmcnt(0)\n\ts_barrier" ::: "memory");
            NAT_ISSUE(it + 3);
            const int lane_ = launder(lane);
            const char* kvb = lds + (it & 3) * 16384;
            const int kr = krlo + it;
            if (it < nlt) { if (kr >= rs && kr < rs + 8) nat_tile<true>(kvb, (const char*)(rpb_s + (kr - row + 7) * 32), c2, qf, boff, O, l, lane_); }
            else nat_tile<false>(kvb, (const char*)rpb_s, c2, qf, boff, O, l, lane_);
        }
        asm volatile("s_waitcnt vmcnt(0)" ::: "memory");
        if (!(isctx && w >= 4)) {
            const int lane_e = launder(lane), li = lane_e & 31, h = lane_e >> 5;
#pragma unroll
            for (int qb = 0; qb < 2; ++qb) {
                float lt = l[qb]; lt += shx(lt, 32, lane_e);
                const float il = 1.f / lt;
                const size_t qoff = ((size_t)(bl * TPB + q0 + 32 * qb + li)) * EI + head * 64;
#pragma unroll
                for (int d = 0; d < 2; ++d)
#pragma unroll
                    for (int g4 = 0; g4 < 4; ++g4) {
                        const int dd = d * 32 + 8 * g4 + 4 * h;
                        const u32x2 zr = *(const u32x2*)(Z + qoff + dd);
                        u32x2 o;
                        o[0] = pack2(O[qb][d][4 * g4 + 0] * il * silu_f(bflo(zr[0])), O[qb][d][4 * g4 + 1] * il * silu_f(bfhi(zr[0])));
                        o[1] = pack2(O[qb][d][4 * g4 + 2] * il * silu_f(bflo(zr[1])), O[qb][d][4 * g4 + 3] * il * silu_f(bfhi(zr[1])));
                        *(u32x2*)(Y + qoff + dd) = o;
                    }
            }
        }
        __syncthreads();
    }
}

DI int chunk_tok0(int cidx) { return cidx < 32 ? cidx * 64 : SEQ + (cidx - 32) * 64; }

__device__ void phase_c_pre(int wid_s, int bid_opaque, const Params& p, int g_, char* lds) {
    PHASE_IDS;
    const float* const conv_b = PF(c_conv_b); const float* const conv_w = PF(c_conv_w);
    const float* const wq_p = PF(c_wq); const float* const wk_p = PF(c_wk); const float* const wv_p = PF(c_wv);
    const bf16_t* const gwt = PF(gwt); float* const gates_o = PF(gates); float* const sbuf_o = PF(sbuf);
    constexpr int XS = 272;
    char* xs = lds;
    char* qs = lds + 18432;
    char* ks = qs + 64 * XS;
    char* vs = ks + 64 * XS;
    float* red = (float*)(vs + 64 * XS);
    const int w = wid_s;
    const bf16_t* XM = PBUF(0); bf16_t* Qf = PBUF(1); bf16_t* KTf = PBUF(2);
    const float kscale = 0.04419417382415922f;
    const int nunits = GB * NCHUNK * 4, G = (int)gridDim.x;
    const bool bal = G == 256;
    const int nsteps = bal ? 9 : (BIDX < nunits ? 4 * ((nunits - BIDX + G - 1) / G) : 0);
    float* const Sp = (float*)(PF(u) + (size_t)(1 - g_) * GT * DM);
    float* const Gp = Sp + 64 * 4 * 4096;
    u32x4 xv[3]; f32x4 cbv, cw[4], wqm[4], wkm[4], wvm[4]; bf16x8 gb[6];
#define CPRE_UNIT(step_) (bal ? ((step_) < 8 ? BIDX + ((step_) >> 2) * 256 : 512 + (BIDX >> 2)) : BIDX + ((step_) >> 2) * G)
#define CPRE_CC(step_) (bal && (step_) >= 8 ? (BIDX & 3) : ((step_) & 3))
#define CPRE_DECODE(step_) const int un_ = CPRE_UNIT(step_), cc_ = CPRE_CC(step_), hd_ = un_ & 3, ci_ = (un_ >> 2) % NCHUNK, bl_ = un_ / (4 * NCHUNK), colb_ = hd_ * 512 + cc_ * 128
#define CPRE_LOADX(step_) do { CPRE_DECODE(step_); const int tid_ = FRESH_TID(); const int tk_ = chunk_tok0(ci_), lo_ = ci_ < 32 ? 0 : SEQ, hi_ = ci_ < 32 ? SEQ : TPB; \
        _Pragma("unroll") for (int i_ = 0; i_ < 3; ++i_) { const int ch_ = tid_ + i_ * NTHREADS, rr_ = ch_ >> 4, c16_ = ch_ & 15, tt_ = tk_ - 2 + rr_; \
            xv[i_] = (u32x4){0u, 0u, 0u, 0u}; if (ch_ < 67 * 16 && tt_ >= lo_ && tt_ < hi_) xv[i_] = *(const u32x4*)(XM + ((size_t)(bl_ * TPB + tt_)) * EI + colb_ + c16_ * 8); } } while (0)
#define CPRE_LOADW(step_) do { CPRE_DECODE(step_); const int nb_ = FRESH_TID() & 31, col_ = colb_ + nb_ * 4, blk_ = col_ >> 2; cbv = *(const f32x4*)(conv_b + col_); \
        _Pragma("unroll") for (int jj = 0; jj < 4; ++jj) { cw[jj] = *(const f32x4*)(conv_w + jj * EI + col_); wqm[jj] = *(const f32x4*)(wq_p + blk_ * 16 + jj * 4); \
            wkm[jj] = *(const f32x4*)(wk_p + blk_ * 16 + jj * 4); wvm[jj] = *(const f32x4*)(wv_p + blk_ * 16 + jj * 4); } } while (0)
#define CPRE_LOADG(step_) do { CPRE_DECODE(step_); const int ln_ = fresh_lane(), r16_ = ln_ & 15, kq_ = ln_ >> 4; \
        _Pragma("unroll") for (int k6 = 0; k6 < 6; ++k6) { const int kk = 6 * (w >> 2) + k6, part = kk >> 2, k32 = kk & 3; \
            gb[k6] = *(const bf16x8*)(gwt + (size_t)r16_ * 6144 + part * 2048 + colb_ + k32 * 32 + kq_ * 8); } } while (0)
    if (nsteps > 0) { CPRE_LOADX(0); CPRE_LOADW(0); CPRE_LOADG(0); }
    f32x4 Sacc[2] = {{0.f, 0.f, 0.f, 0.f}, {0.f, 0.f, 0.f, 0.f}};
    f32x4 Gacc = {0.f, 0.f, 0.f, 0.f};
    for (int step = 0; step < nsteps; ++step) {
        const int unit = CPRE_UNIT(step), cc = CPRE_CC(step);
        const bool part = bal && step >= 8;
        const int head = unit & 3, cidx = (unit >> 2) % NCHUNK, bl = unit / (4 * NCHUNK);
        const int tok0 = chunk_tok0(cidx);
        const size_t cb = (size_t)(bl * 4 + head) * NCHUNK + cidx;
        {
            const int lane = fresh_lane(), tid = w * 64 + lane;
#pragma unroll
            for (int i = 0; i < 3; ++i) { const int ch = tid + i * NTHREADS; if (ch < 67 * 16) *(u32x4*)(xs + (ch >> 4) * XS + (ch & 15) * 16) = xv[i]; }
            __syncthreads();
            if (step + 1 < nsteps) CPRE_LOADX(step + 1);
            const int nb = tid & 31, trow = tid >> 5;
#pragma unroll
            for (int i = 0; i < 4; ++i) {
                const int t = trow + 16 * i;
                f32x4 xr[4];
#pragma unroll
                for (int jj = 0; jj < 4; ++jj) { const u32x2 r2 = *(const u32x2*)(xs + (t + jj) * XS + nb * 8); xr[jj] = (f32x4){bflo(r2[0]), bfhi(r2[0]), bflo(r2[1]), bfhi(r2[1])}; }
                f32x4 xc = cbv;
#pragma unroll
                for (int jj = 0; jj < 4; ++jj) xc += cw[jj] * xr[jj];
#pragma unroll
                for (int e = 0; e < 4; ++e) xc[e] = silu_f(xc[e]);
                f32x4 qv = {0.f, 0.f, 0.f, 0.f}, kv = {0.f, 0.f, 0.f, 0.f}, vv = {0.f, 0.f, 0.f, 0.f};
#pragma unroll
                for (int d = 0; d < 4; ++d) { qv += xc[d] * wqm[d]; kv += xc[d] * wkm[d]; vv += xr[2][d] * wvm[d]; }
                kv *= kscale;
                u32x2 o;
                o[0] = pack2(qv[0], qv[1]); o[1] = pack2(qv[2], qv[3]); *(u32x2*)(qs + t * XS + nb * 8) = o;
                o[0] = pack2(kv[0], kv[1]); o[1] = pack2(kv[2], kv[3]); *(u32x2*)(ks + t * XS + nb * 8) = o;
                o[0] = pack2(vv[0], vv[1]); o[1] = pack2(vv[2], vv[3]); *(u32x2*)(vs + t * XS + nb * 8) = o;
            }
            __syncthreads();
            if (step + 1 < nsteps) CPRE_LOADW(step + 1);
            {
                const int tt = w >> 1, st0 = 2 * (w & 1), r16 = lane & 15, kq = lane >> 4;
#pragma unroll
                for (int kk = 0; kk < 4; ++kk) {
                    const bf16x8 a_ = *(const bf16x8*)(qs + (16 * tt + r16) * XS + kk * 64 + kq * 16);
                    Sacc[0] = MFMA16(a_, *(const bf16x8*)(ks + (16 * st0 + r16) * XS + kk * 64 + kq * 16), Sacc[0]);
                    Sacc[1] = MFMA16(a_, *(const bf16x8*)(ks + (16 * (st0 + 1) + r16) * XS + kk * 64 + kq * 16), Sacc[1]);
                }
                const int gt = w & 3;
#pragma unroll
                for (int k6 = 0; k6 < 6; ++k6) {
                    const int kk = 6 * (w >> 2) + k6, part = kk >> 2, k32 = kk & 3;
                    const char* tile = part == 0 ? qs : (part == 1 ? ks : vs);
                    const bf16x8 a_ = *(const bf16x8*)(tile + (16 * gt + r16) * XS + k32 * 64 + kq * 16);
                    Gacc = MFMA16(a_, gb[k6], Gacc);
                }
            }
            if (step + 1 < nsteps) CPRE_LOADG(step + 1);
            {
                bf16_t* qdst = Qf + (cb * 8 + 2 * cc) * 4096; bf16_t* kdst = KTf + (cb * 8 + 2 * cc) * 4096;
#pragma unroll
                for (int k2 = 0; k2 < 2; ++k2) {
                    const int f = w + 8 * k2, ksf = f & 3, tb = (f >> 2) & 1, ws2 = f >> 3;
                    const int li = lane & 31, h = lane >> 5;
                    const char* qa = qs + (32 * tb + li) * XS + (64 * ws2 + 32 * (ksf >> 1) + 16 * (ksf & 1) + 4 * h) * 2;
                    const u32x2 q0 = *(const u32x2*)qa, q1 = *(const u32x2*)(qa + 16);
                    *(u32x4*)(qdst + (size_t)f * 512 + lane * 8) = (u32x4){q0[0], q0[1], q1[0], q1[1]};
                    const int g = lane >> 4, i16 = lane & 15;
                    const char* ka = ks + (16 * ksf + 8 * (g >> 1) + (i16 >> 2)) * XS + (64 * ws2 + 32 * tb + 16 * (g & 1) + 4 * (i16 & 3)) * 2;
                    const bf16x4 k0 = tr_read(ka), k1 = tr_read(ka + 4 * XS);
                    *(bf16x8*)(kdst + (size_t)f * 512 + lane * 8) = cat4(k0, k1);
                }
            }
            __syncthreads();
        }
        if (part || cc == 3) {
            const int lane = fresh_lane(), r16 = lane & 15, kq = lane >> 4;
            {
                float* So = part ? Sp + (size_t)((unit - 512) * 4 + cc) * 4096 : sbuf_o + cb * 4096;
                const int tt = w >> 1, st0 = 2 * (w & 1);
#pragma unroll
                for (int j = 0; j < 2; ++j)
#pragma unroll
                    for (int r = 0; r < 4; ++r) So[(16 * tt + 4 * kq + r) * 64 + 16 * (st0 + j) + r16] = Sacc[j][r];
            }
#pragma unroll
            for (int r = 0; r < 4; ++r) red[((w >> 2) * 64 + 16 * (w & 3) + 4 * kq + r) * 16 + r16] = Gacc[r];
            __syncthreads();
            for (int o = w * 64 + lane; o < 1024; o += NTHREADS) {
                const int t = o >> 4, gi = o & 15;
                const float gsum = red[t * 16 + gi] + red[(64 + t) * 16 + gi];
                if (part) Gp[(size_t)((unit - 512) * 4 + cc) * 1024 + t * 16 + gi] = gsum; else gates_o[((size_t)(bl * TPB + tok0 + t) * 4 + head) * 16 + gi] = gsum;
            }
            __syncthreads();
            Sacc[0] = (f32x4){0.f, 0.f, 0.f, 0.f}; Sacc[1] = (f32x4){0.f, 0.f, 0.f, 0.f}; Gacc = (f32x4){0.f, 0.f, 0.f, 0.f};
        }
    }
}

__device__ void phase_gwt(int wid_s, int bid_opaque, const Params& p, int cu_lo = 0) {
    PHASE_IDS;
    if (BIDX < cu_lo) return;
    const float* gw = PF(c_gate_w); bf16_t* gwt = PF(gwt);
    for (int i = (BIDX - cu_lo) * NTHREADS + TIDX; i < 16 * 6144; i += ((int)gridDim.x - cu_lo) * NTHREADS) {
        const int n = i / 6144, col = i - n * 6144, dir = n >> 3, g = n & 7;
        float v = gw[((size_t)dir * 6144 + col) * 8 + g];
        if (col >= 2048 && col < 4096) v *= 22.627416997969522f;
        gwt[i] = f2bf(v);
    }
}

__device__ void phase_c_scan(int wid_s, int bid_opaque, const Params& p, int g_, char* lds) {
    PHASE_IDS;
    const auto c_gate_b_k = PF(c_gate_b);
    const auto c_wv_k = PF(c_wv);
    const auto gates_k = PF(gates);
    const auto sbuf_k = PF(sbuf);
    float* TAB = (float*)lds;
    char* PART = lds + 27648;
    float* DENP = (float*)(lds + 105984);
    char* WTS = lds + 108288;
    char* VTL = WTS + 9216;
    char* DVT0 = VTL + 13824;
    float* INTER0 = (float*)(DVT0 + 2 * 13824);
    float* EINV0 = INTER0 + 128;
    float* WVL = EINV0 + 128;
    const int tid0 = TIDX, w = wid_s;
    const bf16_t* XM = PBUF(0); const bf16_t* Q = PBUF(1); const bf16_t* KT = PBUF(2);
#define SCAN_LOADS(cx_, tid_) do { const int so_ = ((tid_) >> 3) * 64 + ((tid_) & 7) * 8; \
        if (bal && bl == 3 && (cx_) >= 20) { const float* pp_ = Sp + (size_t)(((cx_) - 20) * 4 + head) * 4 * 4096 + so_; \
            s0n = *(const f32x4*)pp_ + *(const f32x4*)(pp_ + 4096) + *(const f32x4*)(pp_ + 8192) + *(const f32x4*)(pp_ + 12288); \
            s1n = *(const f32x4*)(pp_ + 4) + *(const f32x4*)(pp_ + 4096 + 4) + *(const f32x4*)(pp_ + 8192 + 4) + *(const f32x4*)(pp_ + 12288 + 4); } \
        else { const float* sp_ = sbuf_k + ((size_t)((bl * 4 + head) * NCHUNK + (cx_))) * 4096 + so_; s0n = *(const f32x4*)sp_; s1n = *(const f32x4*)(sp_ + 4); } } while (0)
    const bool bal = gridDim.x == 256;
    const float* const Sp = (const float*)(PF(u) + (size_t)(1 - g_) * GT * DM);
    const float* const Gp = Sp + 64 * 4 * 4096;
    for (int ibase = 0; ibase < GB * 4 * 2 * 8; ibase += 256) {
        const int item = gridDim.x == 256 ? xcd_unit(ibase, BIDX) : ibase + BIDX;
        if (item >= GB * 4 * 2 * 8 || (gridDim.x != 256 && BIDX >= 256)) continue;
        const int eb = item & 7, dir = (item >> 3) & 1, head = (item >> 4) & 3, bl = item >> 6;
        bf16_t* H = PBUF(3 + dir);
        f32x16 Cacc[2][3];
#pragma unroll
        for (int a_ = 0; a_ < 2; ++a_)
#pragma unroll
            for (int b_ = 0; b_ < 3; ++b_) Cacc[a_][b_] = zero16();
        for (int i = tid0; i < 32 * 72; i += NTHREADS) {
            const int rr = 64 + i / 72, cc = i % 72;
            *(bf16_t*)(VTL + (rr * 72 + cc) * 2) = (rr == 64) ? (bf16_t)0x3F80 : (bf16_t)0;
            *(bf16_t*)(DVT0 + (rr * 72 + cc) * 2) = 0; *(bf16_t*)(DVT0 + 13824 + (rr * 72 + cc) * 2) = 0;
        }
        {
            const int lane = tid0 & 63, t = dir ? 63 - lane : lane;
            for (int st = w; st < NCHUNK; st += 8) {
                const int cidx = dir == 0 ? (st < 4 ? 32 + st : st - 4) : 35 - st;
                const size_t rb = (size_t)bl * TPB + chunk_tok0(cidx);
                const float* gp = gates_k + (rb + t) * 64 + dir * 8 + head;
                float pi = c_gate_b_k[dir * 8 + head], pf = c_gate_b_k[dir * 8 + 4 + head];
                if (bal && bl == 3 && cidx >= 20) {
                    for (int hq = 0; hq < 16; ++hq) { const float* gq_ = Gp + (size_t)((cidx - 20) * 16 + hq) * 1024 + t * 16 + dir * 8 + head; pi += gq_[0]; pf += gq_[4]; }
                } else {
#pragma unroll
                    for (int hh = 0; hh < 4; ++hh) { pi += gp[hh * 16]; pf += gp[hh * 16 + 4]; }
                }
                const float logf = fminf(pf, 0.f) - __logf(1.f + __expf(-fabsf(pf)));
                float bsum = logf;
#pragma unroll
                for (int o = 1; o < 64; o <<= 1) { const float v = shl_from(bsum, lane - o); if (lane >= o) bsum += v; }
                float pm = pi - bsum;
#pragma unroll
                for (int o = 1; o < 64; o <<= 1) { const float v = shl_from(pm, lane - o); if (lane >= o) pm = fmaxf(pm, v); }
                TAB[st * 192 + t] = bsum * 1.4426950408889634f; TAB[st * 192 + 64 + t] = pi * 1.4426950408889634f; TAB[st * 192 + 128 + t] = pm * 1.4426950408889634f;
            }
        }
        float m_prev = 0.f;
        float negm[8];
        { const int t = tid0 >> 3, s8 = (tid0 & 7) * 8;
#pragma unroll
          for (int e = 0; e < 8; ++e) { const int s = s8 + e; negm[e] = (dir ? (s >= t) : (s <= t)) ? 0.f : -1e30f; } }
        if (tid0 < 256) WVL[tid0] = c_wv_k[(size_t)((head * 512 + eb * 64) >> 2) * 16 + tid0];
        f32x4 s0n, s1n; u32x2 xmn[2];
        {
            const int tid = FRESH_TID(), lane = tid & 63;
            const int cidx = dir == 0 ? 32 : 35;
            const size_t rb = (size_t)bl * TPB + chunk_tok0(cidx);
            SCAN_LOADS(cidx, tid);
#pragma unroll
            for (int i = 0; i < 2; ++i) xmn[i] = *(const u32x2*)(XM + (rb + lane) * EI + head * 512 + eb * 64 + (w + 8 * i) * 4);
        }
        bf16x8 qf[2][4], kf[2][4];
        {
            const int lane = fresh_lane();
            const size_t fb = ((((size_t)(bl * 4 + head) * NCHUNK + (dir == 0 ? 32 : 35)) * 8 + w) * 8) * 512 + lane * 8;
#pragma unroll
            for (int f = 0; f < 8; ++f) { qf[f >> 2][f & 3] = *(const bf16x8*)(Q + fb + f * 512); kf[f >> 2][f & 3] = *(const bf16x8*)(KT + fb + f * 512); }
        }
        __syncthreads();
        for (int st = 0; st < NCHUNK; ++st) {
            const int lane = fresh_lane(), tid = w * 64 + lane, li = lane & 31, h = lane >> 5;
            const int cidx = dir == 0 ? (st < 4 ? 32 + st : st - 4) : 35 - st;
            const size_t rb = (size_t)bl * TPB + chunk_tok0(cidx);
            const float* tab = TAB + st * 192;
            char* DVT = DVT0 + (st & 1) * 13824; float* INTER = INTER0 + (st & 1) * 64; float* EINV = EINV0 + (st & 1) * 64;
            const int last = dir ? 0 : 63;
            const float b_last = tab[last], m_new = b_last + fmaxf(m_prev, tab[128 + last]);
            const float carry = __builtin_amdgcn_exp2f(b_last + m_prev - m_new);
            {
                const int t = tid >> 3, s8 = (tid & 7) * 8;
                const float bt = tab[t], mt = bt + fmaxf(m_prev, tab[128 + t]);
                const f32x4 tb0 = *(const f32x4*)(tab + s8), tb1 = *(const f32x4*)(tab + s8 + 4), ti0 = *(const f32x4*)(tab + 64 + s8), ti1 = *(const f32x4*)(tab + 64 + s8 + 4);
                float wv[8];
#pragma unroll
                for (int e = 0; e < 8; ++e) {
                    const float sv = e < 4 ? s0n[e & 3] : s1n[e & 3];
                    const float arg = (bt - mt + negm[e]) - (e < 4 ? tb0[e & 3] : tb1[e & 3]) + (e < 4 ? ti0[e & 3] : ti1[e & 3]);
                    wv[e] = __builtin_amdgcn_exp2f(arg) * sv;
                }
                u32x4 o; o[0] = pack2(wv[0], wv[1]); o[1] = pack2(wv[2], wv[3]); o[2] = pack2(wv[4], wv[5]); o[3] = pack2(wv[6], wv[7]);
                *(u32x4*)(WTS + t * 144 + s8 * 2) = o;
            }
            {
                const int s = lane;
                const float dc = __builtin_amdgcn_exp2f(b_last - tab[s] + tab[64 + s] - m_new);
#pragma unroll
                for (int i = 0; i < 2; ++i) {
                    const int nb = w + 8 * i;
                    f32x4 wvr[4];
#pragma unroll
                    for (int d = 0; d < 4; ++d) wvr[d] = *(const f32x4*)(WVL + nb * 16 + d * 4);
                    const float x0 = bflo(xmn[i][0]), x1 = bfhi(xmn[i][0]), x2 = bflo(xmn[i][1]), x3 = bfhi(xmn[i][1]);
#pragma unroll
                    for (int e = 0; e < 4; ++e) {
                        const float v = x0 * wvr[0][e] + x1 * wvr[1][e] + x2 * wvr[2][e] + x3 * wvr[3][e];
                        *(bf16_t*)(VTL + ((nb * 4 + e) * 72 + s) * 2) = f2bf(v);
                        *(bf16_t*)(DVT + ((nb * 4 + e) * 72 + s) * 2) = f2bf(v * dc);
                    }
                }
                if (w == 7) {
                    const float mt = tab[s] + fmaxf(m_prev, tab[128 + s]);
                    *(bf16_t*)(DVT + (64 * 72 + s) * 2) = f2bf(dc);
                    INTER[s] = __builtin_amdgcn_exp2f(tab[s] + m_prev - mt); EINV[s] = __builtin_amdgcn_exp2f(-mt);
                }
            }
            if (st + 1 < NCHUNK) {
                const int cn = dir == 0 ? (st + 1 < 4 ? 33 + st : st - 3) : 34 - st;
                const size_t rbn = (size_t)bl * TPB + chunk_tok0(cn);
                SCAN_LOADS(cn, tid);
#pragma unroll
                for (int i = 0; i < 2; ++i) xmn[i] = *(const u32x2*)(XM + (rbn + lane) * EI + head * 512 + eb * 64 + (w + 8 * i) * 4);
            }
            __syncthreads();
#pragma unroll
            for (int eo = 0; eo < 3; ++eo) {
                const int ebk = eo == 0 ? 2 : eo - 1;
                bf16x8 cf[4];
#pragma unroll
                for (int ks = 0; ks < 4; ++ks) cf[ks] = pack_acc(Cacc[ks >> 1][ebk], ks & 1);
#pragma unroll
                for (int tb = 0; tb < 2; ++tb) {
                    f32x16 P = zero16();
#pragma unroll
                    for (int ks = 0; ks < 4; ++ks) P = MFMA32(qf[tb][ks], cf[ks], P);
                    if (ebk == 2) {
                        if (li == 0) {
#pragma unroll
                            for (int g4 = 0; g4 < 4; ++g4) *(f32x4*)(DENP + w * 64 + 32 * tb + 8 * g4 + 4 * h) = (f32x4){P[4 * g4], P[4 * g4 + 1], P[4 * g4 + 2], P[4 * g4 + 3]};
                        }
                    } else {
#pragma unroll
                        for (int g4 = 0; g4 < 4; ++g4) {
                            u32x2 o; o[0] = pack2(P[4 * g4], P[4 * g4 + 1]); o[1] = pack2(P[4 * g4 + 2], P[4 * g4 + 3]);
                            *(u32x2*)(PART + (ebk * 9 + w) * 4352 + li * 136 + (32 * tb + 8 * g4 + 4 * h) * 2) = o;
                        }
                    }
                }
                if ((w >> 1) == ebk) {
                    const int hw = w & 1;
                    f32x16 P = zero16();
#pragma unroll
                    for (int ks = 0; ks < 4; ++ks) P = MFMA32(*(const bf16x8*)(WTS + (32 * hw + li) * 144 + ks * 32 + h * 16), *(const bf16x8*)(VTL + (32 * ebk + li) * 144 + ks * 32 + h * 16), P);
                    if (ebk == 2) {
                        if (li == 0) {
#pragma unroll
                            for (int g4 = 0; g4 < 4; ++g4) *(f32x4*)(DENP + 8 * 64 + 32 * hw + 8 * g4 + 4 * h) = (f32x4){P[4 * g4], P[4 * g4 + 1], P[4 * g4 + 2], P[4 * g4 + 3]};
                        }
                    } else {
#pragma unroll
                        for (int g4 = 0; g4 < 4; ++g4) {
                            u32x2 o; o[0] = pack2(P[4 * g4], P[4 * g4 + 1]); o[1] = pack2(P[4 * g4 + 2], P[4 * g4 + 3]);
                            *(u32x2*)(PART + (ebk * 9 + 8) * 4352 + li * 136 + (32 * hw + 8 * g4 + 4 * h) * 2) = o;
                        }
                    }
                }
            }
            const int cnext = dir == 0 ? (st + 1 < 4 ? 33 + st : st - 3) : 34 - st;
            const size_t fbn = ((((size_t)(bl * 4 + head) * NCHUNK + cnext) * 8 + w) * 8) * 512 + lane * 8;
            if (st + 1 < NCHUNK) {
#pragma unroll
                for (int f = 0; f < 8; ++f) qf[f >> 2][f & 3] = *(const bf16x8*)(Q + fbn + f * 512);
            }
            __syncthreads();
            {
                bf16x8 dvf[3][4];
#pragma unroll
                for (int ebk = 0; ebk < 3; ++ebk)
#pragma unroll
                    for (int ks = 0; ks < 4; ++ks) dvf[ebk][ks] = *(const bf16x8*)(DVT + (32 * ebk + li) * 144 + ks * 32 + h * 16);
                asm volatile("" ::: "memory");
#pragma unroll
                for (int db = 0; db < 2; ++db)
#pragma unroll
                    for (int ebk = 0; ebk < 3; ++ebk) {
#pragma unroll
                        for (int r = 0; r < 16; ++r) Cacc[db][ebk][r] *= carry;
                        mfma_c_pad(Cacc[db][ebk]);
#pragma unroll
                        for (int ks = 0; ks < 4; ++ks) Cacc[db][ebk] = MFMA32(kf[db][ks], dvf[ebk][ks], Cacc[db][ebk]);
                    }
            }
            {
                const int e = lane, t0 = 8 * w;
                float dq = DENP[(lane >> 3) * 64 + t0 + (lane & 7)];
                dq += shx(dq, 8, lane); dq += shx(dq, 16, lane); dq += shx(dq, 32, lane);
                const float it_l = INTER[t0 + (lane & 7)];
                const float den_l = it_l * dq + DENP[8 * 64 + t0 + (lane & 7)];
                const float rinv_l = __builtin_amdgcn_rcpf(fmaxf(fabsf(den_l), EINV[t0 + (lane & 7)]));
                float num[8];
#pragma unroll
                for (int jj = 0; jj < 8; ++jj) num[jj] = 0.f;
                const char* pbase = PART + ((e >> 5) * 9) * 4352 + (e & 31) * 136 + t0 * 2;
#pragma unroll
                for (int ww = 0; ww < 8; ++ww) {
                    const u32x2 pa = *(const u32x2*)(pbase + ww * 4352), pb = *(const u32x2*)(pbase + ww * 4352 + 8);
                    const u32x4 pv = {pa[0], pa[1], pb[0], pb[1]};
#pragma unroll
                    for (int q4 = 0; q4 < 4; ++q4) { num[2 * q4] += bflo(pv[q4]); num[2 * q4 + 1] += bfhi(pv[q4]); }
                }
                const u32x2 ia = *(const u32x2*)(pbase + 8 * 4352), ib = *(const u32x2*)(pbase + 8 * 4352 + 8);
                const u32x4 iv = {ia[0], ia[1], ib[0], ib[1]};
#pragma unroll
                for (int jj = 0; jj < 8; ++jj) {
                    const float itj = __uint_as_float((unsigned)__builtin_amdgcn_readlane((int)__float_as_uint(it_l), jj)), rj = __uint_as_float((unsigned)__builtin_amdgcn_readlane((int)__float_as_uint(rinv_l), jj));
                    const float intra = (jj & 1) ? bfhi(iv[jj >> 1]) : bflo(iv[jj >> 1]);
                    H[(rb + t0 + jj) * EI + head * 512 + eb * 64 + e] = f2bf((num[jj] * itj + intra) * rj);
                }
            }
            if (st + 1 < NCHUNK) {
#pragma unroll
                for (int f = 0; f < 8; ++f) kf[f >> 2][f & 3] = *(const bf16x8*)(KT + fbn + f * 512);
            }
            m_prev = m_new;
        }
    }
}

__device__ void phase_c_finish(int wid_s, int bid_opaque, const Params& p) {
    PHASE_IDS;
    const auto c_conv_b_k = PF(c_conv_b);
    const auto c_conv_w_k = PF(c_conv_w);
    const auto c_mhn_g_k = PF(c_mhn_g);
    const auto c_skip_k = PF(c_skip);
    const int tid = TIDX, lane = tid & 63;
    const int gw = BIDX * 8 + (tid >> 6), nw = gridDim.x * 8;
    const bf16_t* XM = PBUF(0); const bf16_t* Zb = PBUF(1); const bf16_t* OG = PBUF(2); const bf16_t* HF = PBUF(3); bf16_t* HB = PBUF(4);
    constexpr int RB = 18;
    for (int task = gw; task < (GT / RB) * 4; task += nw) {
        const int head = task & 3, r0 = (task >> 2) * RB;
        const int col = head * 512 + lane * 8;
        f32x4 cwv[4][2], cbv[2], gv[2], kv[2];
#pragma unroll
        for (int hh = 0; hh < 2; ++hh) {
            cbv[hh] = *(const f32x4*)(c_conv_b_k + col + 4 * hh); gv[hh] = *(const f32x4*)(c_mhn_g_k + col + 4 * hh); kv[hh] = *(const f32x4*)(c_skip_k + col + 4 * hh);
#pragma unroll
            for (int jj = 0; jj < 4; ++jj) cwv[jj][hh] = *(const f32x4*)(c_conv_w_k + jj * EI + col + 4 * hh);
        }
        u32x4 xw[4];
#pragma unroll
        for (int jj = 0; jj < 3; ++jj) { const int rr = r0 + jj - 2; xw[jj] = (rr >= 0) ? *(const u32x4*)(XM + (size_t)rr * EI + col) : (u32x4){0u, 0u, 0u, 0u}; }
        size_t off = (size_t)r0 * EI + col;
        u32x4 hf = *(const u32x4*)(HF + off), hb = *(const u32x4*)(HB + off), og = *(const u32x4*)(OG + off), zz = *(const u32x4*)(Zb + off);
        xw[3] = (r0 + 1 < GT) ? *(const u32x4*)(XM + (size_t)(r0 + 1) * EI + col) : (u32x4){0u, 0u, 0u, 0u};
#pragma unroll 2
        for (int i = 0; i < RB; ++i) {
            const int r = r0 + i, t = r % TPB;
            u32x4 hfn = hf, hbn = hb, ogn = og, zzn = zz, xn = {0u, 0u, 0u, 0u};
            if (i + 1 < RB) {
                const size_t offn = off + EI;
                hfn = *(const u32x4*)(HF + offn); hbn = *(const u32x4*)(HB + offn); ogn = *(const u32x4*)(OG + offn); zzn = *(const u32x4*)(Zb + offn);
                if (r + 2 < GT) xn = *(const u32x4*)(XM + (size_t)(r + 2) * EI + col);
            }
            float x[8]; float s = 0.f;
#pragma unroll
            for (int e = 0; e < 4; ++e) {
                x[2 * e] = (bflo(hf[e]) + bflo(hb[e])) * sigmoid_f(bflo(og[e]));
                x[2 * e + 1] = (bfhi(hf[e]) + bfhi(hb[e])) * sigmoid_f(bfhi(og[e]));
                s += x[2 * e] + x[2 * e + 1];
            }
            const float mu = wave_sum(s, lane) * (1.f / 512.f);
            float q = 0.f;
#pragma unroll
            for (int e = 0; e < 8; ++e) { const float d = x[e] - mu; q += d * d; }
            const float rstd = rsqrtf(wave_sum(q, lane) * (1.f / 512.f) + EPS);
            float xc[8];
#pragma unroll
            for (int e = 0; e < 4; ++e) { xc[e] = cbv[0][e]; xc[4 + e] = cbv[1][e]; }
            const int seq_lo = t < SEQ ? 0 : SEQ, seq_hi = t < SEQ ? SEQ : TPB;
#pragma unroll
            for (int jj = 0; jj < 4; ++jj) {
                const int tt = t + jj - 2;
                const float m = (tt >= seq_lo && tt < seq_hi) ? 1.f : 0.f;
#pragma unroll
                for (int e = 0; e < 4; ++e) {
                    const float lo = bflo(xw[jj][e]), hi = bfhi(xw[jj][e]);
                    const float wl = (2 * e < 4) ? cwv[jj][0][(2 * e) & 3] : cwv[jj][1][(2 * e) & 3], wh = (2 * e + 1 < 4) ? cwv[jj][0][(2 * e + 1) & 3] : cwv[jj][1][(2 * e + 1) & 3];
                    xc[2 * e] += wl * (m * lo); xc[2 * e + 1] += wh * (m * hi);
                }
            }
            float y[8];
#pragma unroll
            for (int e = 0; e < 8; ++e) {
                const float gg = e < 4 ? gv[0][e & 3] : gv[1][e & 3], kk = e < 4 ? kv[0][e & 3] : kv[1][e & 3];
                const float zv = (e & 1) ? bfhi(zz[e >> 1]) : bflo(zz[e >> 1]);
                y[e] = ((x[e] - mu) * rstd * gg + kk * silu_f(xc[e])) * silu_f(zv);
            }
            u32x4 o; o[0] = pack2(y[0], y[1]); o[1] = pack2(y[2], y[3]); o[2] = pack2(y[4], y[5]); o[3] = pack2(y[6], y[7]);
            *(u32x4*)(HB + off) = o;
            hf = hfn; hb = hbn; og = ogn; zz = zzn; xw[0] = xw[1]; xw[1] = xw[2]; xw[2] = xw[3]; xw[3] = xn; off += EI;
        }
    }
}

struct EpiBf16Split {
    bf16_t* o0; bf16_t* o1; int split; int ld;
    DI void operator()(int row, int col, f32x4 v) const {
        bf16_t* o = col < split ? o0 + col : o1 + (col - split);
        u32x2 r; r[0] = pack2(v[0], v[1]); r[1] = pack2(v[2], v[3]); *(u32x2*)(o + (size_t)row * ld) = r;
    }
    DI void store8(int row, int col, f32x4 a, f32x4 b) const {
        bf16_t* o = col < split ? o0 + col : o1 + (col - split);
        u32x4 r; r[0] = pack2(a[0], a[1]); r[1] = pack2(a[2], a[3]); r[2] = pack2(b[0], b[1]); r[3] = pack2(b[2], b[3]); *(u32x4*)(o + (size_t)row * ld) = r;
    }
};

struct EpiBf16Split4 {
    bf16_t* o0;
    DI void operator()(int row, int col, f32x4 v) const {
        u32x2 r; r[0] = pack2(v[0], v[1]); r[1] = pack2(v[2], v[3]); *(u32x2*)(o0 + (size_t)(col >> 11) * BUFE + (size_t)row * EI + (col & 2047)) = r;
    }
    DI void store8(int row, int col, f32x4 a, f32x4 b) const {
        u32x4 r; r[0] = pack2(a[0], a[1]); r[1] = pack2(a[2], a[3]); r[2] = pack2(b[0], b[1]); r[3] = pack2(b[2], b[3]); *(u32x4*)(o0 + (size_t)(col >> 11) * BUFE + (size_t)row * EI + (col & 2047)) = r;
    }
};

template <int KIND>
__device__ __forceinline__ void run_phase(const Params& p, int ph, char* lds, int wid_s) {
    const int bid_opaque = launder_s((int)__builtin_amdgcn_workgroup_id_x());
    const int code = PPROG(ph), kind = KIND >= 0 ? KIND : (code & 0xff), layer = (code >> 8) & 0xff, g = (code >> 16) & 0xff;
    const int type = layer % 3, j = layer / 3;
    const bf16_t* ug = PF(u) + (size_t)g * GT * DM;
    bf16_t* const winb = (layer & 1) ? PF(win2) : PF(win);
    const int lo_sel = (code >> 26) & 7, cu_lo = lo_sel == 0 ? 0 : lo_sel == 1 ? 64 : lo_sel == 2 ? 160 : lo_sel == 3 ? 176 : 128;
    switch (kind) {
    case PH_MOD:
        phase_mod(wid_s, bid_opaque, p, lds);
        phase_wconv(wid_s, bid_opaque, PF(a_w_in), PF(win), DM, 4 * EI, lds, 0, 1);
        break;
    case PH_NORM: phase_norm(wid_s, bid_opaque, p, layer, g, cu_lo); break;
    case PH_WCONV: {
        const float* wi = type == 0 ? PF(a_w_in) + (size_t)j * DM * 4 * EI : type == 1 ? PF(b_w_in) : PF(c_w_in);
        const float* wo = type == 0 ? PF(a_w_out) + (size_t)j * EI * DM : type == 1 ? PF(b_w_out) : PF(c_w_out);
        if (g == 0) { phase_wconv(wid_s, bid_opaque, wi, winb, DM, type == 2 ? 3 * EI : 4 * EI, lds, cu_lo, type != 2); if (type == 2) phase_gwt(wid_s, bid_opaque, p, cu_lo); }
        else phase_wconv(wid_s, bid_opaque, wo, PF(wout), EI, DM, lds, cu_lo);
    } break;
    case PH_AB_INPROJ: {
        const int c0 = (code >> 24) & 1 ? (layer == 3 && g == 1 ? 128 : 144) : 0;
        phase_inproj_ab(wid_s, bid_opaque, ug, winb, PBUF(0), type == 0 ? PF(a_kn_g) + j * 64 : PF(b_kn_g), type == 0, lds, c0);
    } break;
    case PH_A_ATTN: {
        float gq = 0.f, gk = 0.f;
        for (int i = 0; i < 64; ++i) { gq = fmaxf(gq, fabsf(PF(a_qn_g)[j * 64 + i])); gk = fmaxf(gk, fabsf(PF(a_kn_g)[j * 64 + i])); }
        if (8.f * gq * gk * 1.4426950408889634f > 100.f) phase_attn_a<true>(wid_s, bid_opaque, p, layer, j, layer < 3, lds);
        else phase_attn_a<false>(wid_s, bid_opaque, p, layer, j, layer < 3, lds);
    } break;
    case PH_B_ATTN: phase_attn_b(wid_s, bid_opaque, p, 1, lds); break;
    case PH_OUTPROJ: gemm_pg8(wid_s, bid_opaque, PBUF(4), PF(wout), layer == 3 ? GB * SEQ : GT, DM, EI, EpiResid{resid_ptrs(layer == 0), layer, g * GT, layer == 3}, lds, 0, layer == 3); break;
    case PH_C_INPROJ: gemm_pg8(wid_s, bid_opaque, ug, winb, GT, EI, DM, EpiBf16{PBUF(0), EI, 1.f}, lds, (code >> 24) & 1 ? 144 : 0); break;
    case PH_C_PRE: phase_c_pre(wid_s, bid_opaque, p, g, lds); break;
    case PH_C_SCAN: phase_c_scan(wid_s, bid_opaque, p, g, lds); break;
    case PH_C_ZOG: gemm_pg8(wid_s, bid_opaque, ug, winb + (size_t)EI * DM, GT, 2 * EI, DM, EpiBf16Split{PBUF(1), PBUF(2), EI, EI}, lds); break;
    case PH_C_FINISH: phase_c_finish(wid_s, bid_opaque, p); break;
    default: break;
    }
}

#if 1
#define XB_TMO      128
#define XB_XCNT(j)  (256  + 64 * (j))
#define XB_XSUB(j)  (1280 + 64 * (j))
#define XB_XGEN(j)  (2304 + 64 * (j))
#define XB_TOP      3328
#define XB_TOPGEN   3392
#define XCD_BAR_WORDS 3456
#define XB_SPIN_CAP (1u << 18)

__device__ __forceinline__ unsigned xb_ld(unsigned* p)              { return __hip_atomic_load(p, __ATOMIC_RELAXED, __HIP_MEMORY_SCOPE_AGENT); }
__device__ __forceinline__ unsigned xb_add(unsigned* p, unsigned v) { return __hip_atomic_fetch_add(p, v, __ATOMIC_RELAXED, __HIP_MEMORY_SCOPE_AGENT); }
__device__ __forceinline__ unsigned xb_xcc_id() { return (unsigned)__builtin_amdgcn_s_getreg((3 << 11) | 20) & 0xFu; }
#define XB_SPIN(cond, bar) do { unsigned _sp = 0; while (cond) { __builtin_amdgcn_s_sleep(1); \
    if ((++_sp & 255u) == 0u) { if (xb_ld(&(bar)[XB_TMO])) break; if (_sp > XB_SPIN_CAP) { atomicAdd(&(bar)[XB_TMO], 1u); break; } } } } while (0)

struct XcdBarrier {
    unsigned* bar; unsigned x;
    volatile LAS unsigned* st;
};

__device__ __forceinline__ XcdBarrier xcd_barrier_post(unsigned* bar, volatile LAS unsigned* st, bool leader) {
    XcdBarrier b; b.bar = bar; b.x = xb_xcc_id(); b.st = st;
    if (leader) (void)xb_add(&bar[XB_XCNT(b.x)], 1u);
    return b;
}
__device__ __forceinline__ void xcd_barrier_complete(unsigned* bar, unsigned x, unsigned& nloc, unsigned& nx) {
    const unsigned G = gridDim.x * gridDim.y * gridDim.z;
    unsigned sum, cnt, mine, sp = 0u;
    for (;;) {
        sum = 0u; cnt = 0u; mine = 0u;
#pragma unroll
        for (unsigned j = 0; j < 16; ++j) { const unsigned c = xb_ld(&bar[XB_XCNT(j)]); sum += c; cnt += (c > 0u) ? 1u : 0u; mine = (j == x) ? c : mine; }
        if (sum == G) break;
        __builtin_amdgcn_s_sleep(1);
        if ((++sp & 255u) == 0u) { if (xb_ld(&bar[XB_TMO])) break; if (sp > XB_SPIN_CAP) { atomicAdd(&bar[XB_TMO], 1u); break; } }
    }
    nloc = mine > 0u ? mine : 1u; nx = cnt > 0u ? cnt : 1u;
}

__device__ __forceinline__ void xcd_barrier(const XcdBarrier& b, bool leader) {
    asm volatile("s_waitcnt vmcnt(0)" ::: "memory");
    __syncthreads();
    if (leader) {
        unsigned* bar = b.bar;
        __builtin_amdgcn_s_waitcnt(0);
        unsigned nloc = b.st[0], nx = b.st[1];
        if (nloc == 0u) { xcd_barrier_complete(bar, b.x, nloc, nx); b.st[0] = nloc; b.st[1] = nx; }
        const unsigned old = xb_add(&bar[XB_XSUB(b.x)], 1u);
        const unsigned gen = old / nloc;
        if (old + 1u == (gen + 1u) * nloc) {
            __builtin_amdgcn_fence(__ATOMIC_RELEASE, "agent");
            asm volatile("s_waitcnt vmcnt(0)" ::: "memory");
            const unsigned og = xb_add(&bar[XB_TOP], 1u);
            const unsigned tg = og / nx;
            if (og + 1u == (tg + 1u) * nx) xb_add(&bar[XB_TOPGEN], 1u);
            else XB_SPIN(xb_ld(&bar[XB_TOPGEN]) == tg, bar);
            __builtin_amdgcn_fence(__ATOMIC_ACQUIRE, "agent");
            xb_add(&bar[XB_XGEN(b.x)], 1u);
            asm volatile("s_waitcnt vmcnt(0)" ::: "memory");
        } else {
            XB_SPIN(xb_ld(&bar[XB_XGEN(b.x)]) == gen, bar);
            __builtin_amdgcn_fence(__ATOMIC_ACQUIRE, "agent");
            asm volatile("s_waitcnt vmcnt(0)" ::: "memory");
        }
    }
    __syncthreads();
}

__device__ __forceinline__ void grid_barrier(unsigned* ctr, unsigned epoch, unsigned nblocks) {
    asm volatile("s_waitcnt vmcnt(0)" ::: "memory");
    __syncthreads();
    if (threadIdx.x == 0) {
        __builtin_amdgcn_fence(__ATOMIC_RELEASE, "agent");
        asm volatile("s_waitcnt vmcnt(0)" ::: "memory");
        __hip_atomic_fetch_add(ctr, 1u, __ATOMIC_RELAXED, __HIP_MEMORY_SCOPE_AGENT);
        const unsigned want = epoch * nblocks;
        while (__hip_atomic_load(ctr, __ATOMIC_RELAXED, __HIP_MEMORY_SCOPE_AGENT) < want) __builtin_amdgcn_s_sleep(2);
        __builtin_amdgcn_fence(__ATOMIC_ACQUIRE, "agent");
        asm volatile("s_waitcnt vmcnt(0)" ::: "memory");
    }
    __syncthreads();
}
__global__ void __launch_bounds__(NTHREADS) mk_fwd(Params p, int ph_lo, int ph_hi, int use_sync) {
    extern __shared__ __attribute__((aligned(16))) char lds[];
    const int wid_s = __builtin_amdgcn_readfirstlane((int)__builtin_amdgcn_workitem_id_x() >> 6);
#ifndef MK_HYBRID
    cg::this_grid().sync();
#endif
    volatile LAS unsigned* xb_st = (volatile LAS unsigned*)((LAS char*)lds + LDS_BYTES - 16);
    if (threadIdx.x < 4) xb_st[threadIdx.x] = 0u;
    __syncthreads();
    const XcdBarrier xb = xcd_barrier_post(PF(bar), xb_st, threadIdx.x == 0);
    for (int ph = ph_lo; ph < ph_hi; ++ph) {
        run_phase<-1>(p, ph, lds, wid_s);
#ifdef REPMASK
        if ((REPMASK >> (PPROG(ph) & 0xff)) & 1) { xcd_barrier(xb, wid_s == 0 && fresh_lane() == 0); run_phase<-1>(p, ph, lds, wid_s); }
#endif
        if ((PPROG(ph) >> 25) & 1) __syncthreads();
        else if (use_sync && ph + 1 < ph_hi) xcd_barrier(xb, wid_s == 0 && fresh_lane() == 0);
    }
}
#endif
#ifdef MK_HYBRID
template <int KIND>
__global__ void __launch_bounds__(NTHREADS) mk_one(Params p, int ph) {
    extern __shared__ __attribute__((aligned(16))) char lds[];
    run_phase<KIND>(p, ph, lds, __builtin_amdgcn_readfirstlane((int)__builtin_amdgcn_workitem_id_x() >> 6));
}
typedef void (*phase_kernel_t)(Params, int);
static phase_kernel_t phase_kernel(int kind) {
    switch (kind) {
    case PH_MOD: return mk_one<PH_MOD>; case PH_PREP: return mk_one<PH_PREP>; case PH_AB_INPROJ: return mk_one<PH_AB_INPROJ>; case PH_AB_QKNORM: return mk_one<PH_AB_QKNORM>;
    case PH_A_ATTN: return mk_one<PH_A_ATTN>; case PH_B_ATTN: return mk_one<PH_B_ATTN>; case PH_OUTPROJ: return mk_one<PH_OUTPROJ>; case PH_C_INPROJ: return mk_one<PH_C_INPROJ>;
    case PH_C_PRE: return mk_one<PH_C_PRE>; case PH_C_SCAN: return mk_one<PH_C_SCAN>; case PH_C_ZOG: return mk_one<PH_C_ZOG>; default: return mk_one<PH_C_FINISH>;
    }
}
#endif

static size_t align_up(size_t v, size_t a) { return (v + a - 1) / a * a; }

extern "C" void kernel_launch(void* const* d_in, const int* in_sizes, int n_in, void* d_out, int out_size, void* d_ws, size_t ws_size, hipStream_t stream) {
    static int grid = 0;
    Params p{};
    if (n_in != 29) { fprintf(stderr, "kernel_launch: expected 29 inputs, got %d\n", n_in); return; }
    const float** ip = (const float**)&p.x;
    for (int i = 0; i < 29; ++i) ip[i] = (const float*)d_in[i];
    p.out = (float*)d_out; p.bar = (unsigned*)d_ws;
    char* ws = (char*)d_ws; size_t off = 16384;
    p.mod = (float*)(ws + off); off = align_up(off + (size_t)4 * 9 * 3072 * 4, 256);
    p.hctx = (float*)(ws + off); off = align_up(off + (size_t)NBATCH * CTXL * DM * 4, 256);
    p.win = (bf16_t*)(ws + off); off = align_up(off + (size_t)4 * EI * DM * 2, 256);
    p.win2 = (bf16_t*)(ws + off); off = align_up(off + (size_t)4 * EI * DM * 2, 256);
    p.wout = (bf16_t*)(ws + off); off = align_up(off + (size_t)DM * EI * 2, 256);
    p.u = (bf16_t*)(ws + off); off = align_up(off + (size_t)NTOK * DM * 2, 256);
    for (int i = 0; i < 5; ++i) { p.buf[i] = (bf16_t*)(ws + off); off = align_up(off + BUFE * 2, 256); }
    p.sbuf = (float*)(ws + off); off = align_up(off + (size_t)GB * 4 * NCHUNK * 4096 * 4, 256);
    p.gates = (float*)(ws + off); off = align_up(off + (size_t)GT * 64 * 4, 256);
    p.gwt = (bf16_t*)(ws + off); off = align_up(off + (size_t)16 * 6144 * 2, 256);
    if (off > ws_size) { fprintf(stderr, "kernel_launch: workspace too small: need %zu have %zu\n", off, ws_size); return; }
    int n = 0;
    auto add = [&](int kind, int layer, int g) { p.prog[n++] = kind | (layer << 8) | (g << 16); };
    const int NB = 1 << 25, MG = 1 << 24, LO64 = 1 << 26, LO160 = 2 << 26, LO176 = 3 << 26, LO128 = 4 << 26;
    add(PH_MOD, 0, 0);
    add(PH_NORM, 0, 0);
    add(PH_AB_INPROJ | NB, 0, 0); add(PH_NORM | LO128 | NB, 0, 1); add(PH_WCONV | LO128, 0, 1);
    add(PH_A_ATTN, 0, 0);
    add(PH_OUTPROJ | NB, 0, 0); add(PH_AB_INPROJ | MG | NB, 0, 1); add(PH_WCONV | LO160, 1, 0);
    add(PH_A_ATTN | NB, 0, 1); add(PH_NORM, 1, 0);
    add(PH_OUTPROJ | NB, 0, 1); add(PH_AB_INPROJ | MG, 1, 0);
    add(PH_B_ATTN | NB, 1, 0); add(PH_NORM | NB, 1, 1); add(PH_WCONV, 1, 1);
    add(PH_OUTPROJ | NB, 1, 0); add(PH_AB_INPROJ | MG | NB, 1, 1); add(PH_WCONV | LO160, 2, 0);
    add(PH_B_ATTN | NB, 1, 1); add(PH_NORM, 2, 0);
    add(PH_OUTPROJ | NB, 1, 1); add(PH_C_INPROJ | MG | NB, 2, 0); add(PH_WCONV | LO176, 3, 0);
    add(PH_C_PRE, 2, 0); add(PH_C_SCAN, 2, 0);
    add(PH_C_ZOG | NB, 2, 0); add(PH_NORM | LO64 | NB, 2, 1); add(PH_WCONV | LO64, 2, 1);
    add(PH_C_FINISH, 2, 0);
    add(PH_OUTPROJ | NB, 2, 0); add(PH_C_INPROJ | MG, 2, 1);
    add(PH_C_PRE, 2, 1); add(PH_C_SCAN, 2, 1);
    add(PH_C_ZOG | NB, 2, 1); add(PH_NORM | LO64, 3, 0);
    add(PH_C_FINISH, 2, 1);
    add(PH_OUTPROJ | NB, 2, 1); add(PH_AB_INPROJ | MG, 3, 0);
    add(PH_A_ATTN | NB, 3, 0); add(PH_NORM | NB, 3, 1); add(PH_WCONV, 3, 1);
    add(PH_OUTPROJ | NB, 3, 0); add(PH_AB_INPROJ | MG, 3, 1);
    add(PH_A_ATTN, 3, 1);
    add(PH_OUTPROJ, 3, 1);
    p.nphases = n;
#ifdef MK_HYBRID
    if (grid == 0) {
        for (int k = 0; k <= PH_C_FINISH; ++k)
            if (hipFuncSetAttribute((const void*)phase_kernel(k), hipFuncAttributeMaxDynamicSharedMemorySize, LDS_BYTES) != hipSuccess) { grid = -1; return; }
        if (hipFuncSetAttribute((const void*)mk_fwd, hipFuncAttributeMaxDynamicSharedMemorySize, LDS_BYTES) != hipSuccess) { grid = -1; return; }
        grid = 256;
    }
    if (grid < 0) return;
    for (int ph = 0; ph < p.nphases; ++ph) {
        const int kind = p.prog[ph] & 0xff;
        if ((MK_HYBRID >> kind) & 1) hipLaunchKernelGGL(mk_fwd, dim3(grid), dim3(NTHREADS), LDS_BYTES, stream, p, ph, ph + 1, 0);
        else hipLaunchKernelGGL(phase_kernel(kind), dim3(grid), dim3(NTHREADS), LDS_BYTES, stream, p, ph);
    }
#else
    if (grid == 0) {
        if (hipFuncSetAttribute((const void*)mk_fwd, hipFuncAttributeMaxDynamicSharedMemorySize, LDS_BYTES) != hipSuccess) { fprintf(stderr, "kernel_launch: hipFuncSetAttribute failed\n"); grid = -1; return; }
        int dev = 0, cus = 0, per_cu = 0;
        if (hipGetDevice(&dev) != hipSuccess || hipDeviceGetAttribute(&cus, hipDeviceAttributeMultiprocessorCount, dev) != hipSuccess || cus <= 0) { fprintf(stderr, "kernel_launch: device query failed\n"); grid = -1; return; }
        if (hipOccupancyMaxActiveBlocksPerMultiprocessor(&per_cu, (const void*)mk_fwd, NTHREADS, LDS_BYTES) != hipSuccess || per_cu < 1) { fprintf(stderr, "kernel_launch: occupancy query failed (%d)\n", per_cu); grid = -1; return; }
        grid = cus;
    }
    if (grid < 0) return;
    if (hipMemsetAsync(d_ws, 0, 16384, stream) != hipSuccess) { fprintf(stderr, "kernel_launch: memset failed\n"); return; }
    int ph_lo = 0, ph_hi = p.nphases, use_sync = 1;
    void* args[] = {&p, &ph_lo, &ph_hi, &use_sync};
    const hipError_t e = hipLaunchCooperativeKernel((const void*)mk_fwd, dim3(grid), dim3(NTHREADS), args, LDS_BYTES, stream);
    if (e != hipSuccess) fprintf(stderr, "kernel_launch: cooperative launch failed: %s (grid %d)\n", hipGetErrorString(e), grid);
#endif
}
```

```cpp
#include <hip/hip_runtime.h>
#include <hip/hip_cooperative_groups.h>
#include <stdint.h>
#include <stdio.h>
namespace cg = cooperative_groups;

typedef unsigned short bf16_t;
typedef short bf16x8 __attribute__((ext_vector_type(8)));
typedef short bf16x4 __attribute__((ext_vector_type(4)));
typedef float f32x2 __attribute__((ext_vector_type(2)));
typedef float f32x4 __attribute__((ext_vector_type(4)));
typedef float f32x16 __attribute__((ext_vector_type(16)));
typedef __bf16 bf16x2v __attribute__((ext_vector_type(2)));
typedef unsigned u32x2 __attribute__((ext_vector_type(2)));
typedef unsigned u32x4 __attribute__((ext_vector_type(4)));

#define DI __device__ __forceinline__
#define MFMA32(a, b, c) __builtin_amdgcn_mfma_f32_32x32x16_bf16((a), (b), (c), 0, 0, 0)
#define MFMA16(a, b, c) __builtin_amdgcn_mfma_f32_16x16x32_bf16((a), (b), (c), 0, 0, 0)

constexpr int DM = 1024;
constexpr int EI = 2048;
constexpr int NBATCH = 8;
constexpr int SEQ = 2048;
constexpr int CTXL = 256;
constexpr int TPB = SEQ + CTXL;
constexpr int NTOK = NBATCH * TPB;
constexpr int GB = 4;
constexpr int GT = GB * TPB;
constexpr int NGROUP = NBATCH / GB;
constexpr float EPS = 1e-6f;
constexpr int NTHREADS = 512;
constexpr size_t BUFE = (size_t)GT * EI;
constexpr int NCHUNK = TPB / 64;
constexpr int LDS_BYTES = 160 * 1024;

enum { PH_MOD = 0, PH_PREP, PH_AB_INPROJ, PH_AB_QKNORM, PH_A_ATTN, PH_B_ATTN, PH_OUTPROJ, PH_C_INPROJ, PH_C_PRE, PH_C_SCAN, PH_C_ZOG, PH_C_FINISH, PH_NORM, PH_WCONV };
constexpr int MAX_PHASES = 64;
#ifndef PH_LIMIT
#define PH_LIMIT 1000
#endif

struct Params {
    const float *x, *c, *ctx, *c_ctx, *mod_w, *mod_b, *norm_g;
    const float *a_w_in, *a_w_out, *a_qn_g, *a_kn_g, *a_lam, *a_subln_g;
    const float *b_w_in, *b_w_out, *b_qn_g, *b_kn_g, *b_rpb;
    const float *c_w_in, *c_conv_w, *c_conv_b, *c_wq, *c_wk, *c_wv, *c_gate_w, *c_gate_b, *c_mhn_g, *c_skip, *c_w_out;
    unsigned* bar;
    float* out;
    float* mod;
    float* hctx;
    bf16_t* win; bf16_t* win2;
    bf16_t* wout;
    bf16_t* u;
    bf16_t* buf[5];
    float* sbuf;
    float* gates;
    bf16_t* gwt;
    int nphases;
    int pad_;
    long long pad2_;
    int prog[MAX_PHASES];
};


template <class T> __device__ __forceinline__ T karg(int off) { asm volatile("" : "+s"(off)); return *(const T*)((const char*)__builtin_amdgcn_kernarg_segment_ptr() + off); }
#define PF(name) karg<decltype(Params::name)>((int)__builtin_offsetof(Params, name))
#define PBUF(i) karg<bf16_t*>((int)__builtin_offsetof(Params, buf) + 8 * (i))
#define PPROG(i) karg<int>((int)__builtin_offsetof(Params, prog) + 4 * (i))
#define PHASE_IDS int lane_v_; asm volatile("s_nop 7\n\ts_nop 7\n\ts_nop 7\n\tv_mbcnt_lo_u32_b32 %0, -1, 0\n\tv_mbcnt_hi_u32_b32 %0, -1, %0" : "=v"(lane_v_)); const int tid_opaque = wid_s * 64 + lane_v_
DI int fresh_lane() { int l; asm volatile("s_nop 7\n\ts_nop 7\n\ts_nop 7\n\tv_mbcnt_lo_u32_b32 %0, -1, 0\n\tv_mbcnt_hi_u32_b32 %0, -1, %0" : "=v"(l)); return l; }
#define FRESH_TID() (wid_s * 64 + fresh_lane())
#define TIDX (tid_opaque)
#define BIDX (bid_opaque)
DI unsigned pack2(float lo, float hi) { f32x2 v = {lo, hi}; bf16x2v b = __builtin_convertvector(v, bf16x2v); return __builtin_bit_cast(unsigned, b); }
DI bf16_t f2bf(float x) { return (bf16_t)(pack2(x, 0.f) & 0xffffu); }
DI float bf2f(bf16_t v) { return __uint_as_float(((unsigned)v) << 16); }
DI float bflo(unsigned w) { return __uint_as_float(w << 16); }
DI float bfhi(unsigned w) { return __uint_as_float(w & 0xffff0000u); }
DI float shx(float v, int o, int lane) { return __uint_as_float((unsigned)__builtin_amdgcn_ds_bpermute((lane ^ o) << 2, (int)__float_as_uint(v))); }
DI float shl_from(float v, int src_lane) { return __uint_as_float((unsigned)__builtin_amdgcn_ds_bpermute((src_lane & 63) << 2, (int)__float_as_uint(v))); }
DI float wave_sum(float v, int lane) {
#pragma unroll
    for (int o = 32; o; o >>= 1) v += shx(v, o, lane);
    return v;
}
DI float wave_max(float v, int lane) {
#pragma unroll
    for (int o = 32; o; o >>= 1) v = fmaxf(v, shx(v, o, lane));
    return v;
}
DI float silu_f(float x) { return x / (1.f + __expf(-x)); }
DI float sigmoid_f(float x) { return 1.f / (1.f + __expf(-x)); }
DI bf16x8 pack_acc(const f32x16& x, int s) {
    u32x4 p;
    p[0] = pack2(x[8 * s + 0], x[8 * s + 1]); p[1] = pack2(x[8 * s + 2], x[8 * s + 3]);
    p[2] = pack2(x[8 * s + 4], x[8 * s + 5]); p[3] = pack2(x[8 * s + 6], x[8 * s + 7]);
    return __builtin_bit_cast(bf16x8, p);
}
DI bf16x8 cat4(bf16x4 lo, bf16x4 hi) { bf16x8 r; r[0] = lo[0]; r[1] = lo[1]; r[2] = lo[2]; r[3] = lo[3]; r[4] = hi[0]; r[5] = hi[1]; r[6] = hi[2]; r[7] = hi[3]; return r; }
DI int launder(int x) { asm volatile("" : "+v"(x)); return x; }
DI int launder_s(int x) { asm volatile("" : "+s"(x)); return x; }
DI void mfma_c_pad(f32x16& x) { asm volatile("s_nop 15" : "+v"(x)); }
DI int xcd_unit(int base, int bid) { return base + (bid & 7) * 32 + (bid >> 3); }
DI f32x16 zero16() { f32x16 z; for (int i = 0; i < 16; ++i) z[i] = 0.f; return z; }

struct ResidPtrs { const float* src_lat; const float* src_ctx; float* out; float* hctx; const float* mod; };
DI ResidPtrs resid_ptrs(int layer_src_is_input) { ResidPtrs r; r.out = PF(out); r.hctx = PF(hctx); r.mod = PF(mod); r.src_lat = layer_src_is_input ? PF(x) : (const float*)r.out; r.src_ctx = layer_src_is_input ? PF(ctx) : (const float*)r.hctx; return r; }
DI const float* resid_ptr(const ResidPtrs& rp, int R, int& v) {
    const int b = R / TPB, t = R - b * TPB;
    if (t < SEQ) { v = b; return rp.src_lat + ((size_t)b * SEQ + t) * DM; }
    v = 8; return rp.src_ctx + ((size_t)b * CTXL + (t - SEQ)) * DM;
}

__device__ void phase_mod(int wid_s, int bid_opaque, const Params& p, char* ldsc) {
    PHASE_IDS;
    const auto c_k = PF(c);
    const auto c_ctx_k = PF(c_ctx);
    const auto mod_k = PF(mod);
    const auto mod_b_k = PF(mod_b);
    const auto mod_w_k = PF(mod_w);
    float* sc = (float*)ldsc;
    float* red = sc + 9 * 1024;
    const int tid = TIDX, lane = tid & 63, w = tid >> 6;
    for (int i = tid; i < 9 * 1024; i += NTHREADS) { const int v = i >> 10, k = i & 1023; const float cv = v < 8 ? c_k[v * 1024 + k] : c_ctx_k[k]; sc[i] = silu_f(cv); }
    __syncthreads();
    for (int unit = BIDX; unit < 4 * 64; unit += gridDim.x) {
        const int l = unit >> 6, n0 = (unit & 63) * 48;
        const int cl = lane < 48 ? lane : 47;
        float acc[9];
#pragma unroll
        for (int v = 0; v < 9; ++v) acc[v] = 0.f;
        const float* wp = mod_w_k + (size_t)l * 1024 * 3072 + n0 + cl;
        for (int k0 = w; k0 < 1024; k0 += 128) {
            float wv[16];
#pragma unroll
            for (int j = 0; j < 16; ++j) wv[j] = wp[(size_t)(k0 + 8 * j) * 3072];
#pragma unroll
            for (int j = 0; j < 16; ++j)
#pragma unroll
                for (int v = 0; v < 9; ++v) acc[v] += sc[v * 1024 + k0 + 8 * j] * wv[j];
        }
#pragma unroll
        for (int v = 0; v < 9; ++v) red[(w * 9 + v) * 64 + lane] = acc[v];
        __syncthreads();
        for (int i = tid; i < 9 * 64; i += NTHREADS) {
            const int v = i >> 6, col = i & 63; float s = 0.f;
#pragma unroll
            for (int ww = 0; ww < 8; ++ww) s += red[(ww * 9 + v) * 64 + col];
            if (col < 48) mod_k[(l * 9 + v) * 3072 + n0 + col] = s + mod_b_k[l * 3072 + n0 + col];
        }
        __syncthreads();
    }
}

__device__ void phase_norm(int wid_s, int bid_opaque, const Params& p, int layer, int g_, int cu_lo = 0) {
    PHASE_IDS;
    const int tid = TIDX, lane = tid & 63;
    if (BIDX < cu_lo) return;
    const int gw = (BIDX - cu_lo) * 8 + (tid >> 6), nw = ((int)gridDim.x - cu_lo) * 8;
    const float* g = PF(norm_g) + layer * DM;
    const ResidPtrs rp = resid_ptrs(layer == 0);
    bf16_t* const u_ = PF(u);
    f32x4 gg[4], sh[4], scl[4];
#pragma unroll
    for (int i = 0; i < 4; ++i) gg[i] = *(const f32x4*)(g + i * 256 + lane * 4);
    for (int blk = gw >> 1; blk < GT / 9; blk += nw >> 1) {
        const int r_lo = g_ * GT + blk * 9 + (gw & 1) * 5, nr = (gw & 1) ? 4 : 5;
        int vcur = -1;
        for (int k = 0; k < nr; ++k) {
            const int R = r_lo + k;
            int v; const float* src = resid_ptr(rp, R, v);
            f32x4 xv[4]; float ss = 0.f;
#pragma unroll
            for (int i = 0; i < 4; ++i) { xv[i] = *(const f32x4*)(src + i * 256 + lane * 4); ss += xv[i][0] * xv[i][0] + xv[i][1] * xv[i][1] + xv[i][2] * xv[i][2] + xv[i][3] * xv[i][3]; }
            if (v != vcur) {
                vcur = v;
                const float* mv = rp.mod + (layer * 9 + v) * 3072;
#pragma unroll
                for (int i = 0; i < 4; ++i) { sh[i] = *(const f32x4*)(mv + i * 256 + lane * 4); scl[i] = *(const f32x4*)(mv + 1024 + i * 256 + lane * 4); }
            }
            ss = wave_sum(ss, lane);
            const float rstd = rsqrtf(ss * (1.f / DM) + EPS);
#pragma unroll
            for (int i = 0; i < 4; ++i) {
                const int col = i * 256 + lane * 4;
                f32x4 y;
#pragma unroll
                for (int e = 0; e < 4; ++e) y[e] = xv[i][e] * rstd * gg[i][e] * (1.f + scl[i][e]) + sh[i][e];
                u32x2 o; o[0] = pack2(y[0], y[1]); o[1] = pack2(y[2], y[3]);
                *(u32x2*)(u_ + (size_t)R * DM + col) = o;
            }
        }
    }
}

__device__ void phase_wconv(int wid_s, int bid_opaque, const float* W, bf16_t* Wt, int K, int N, char* ldsc, int cu_lo = 0, int permk = 0) {
    PHASE_IDS;
    if (BIDX < cu_lo) return;
    const int tid = TIDX;
    const int tilesN = N / 64, tiles = (K / 64) * tilesN, G = (int)gridDim.x - cu_lo;
    const int nn = (tid & 15) * 4;
    f32x4 v[2];
    int unit = BIDX - cu_lo;
    if (unit < tiles) {
        const int k0 = (unit / tilesN) * 64, n0 = (unit % tilesN) * 64;
#pragma unroll
        for (int hh = 0; hh < 2; ++hh) v[hh] = *(const f32x4*)(W + (size_t)(k0 + (tid >> 4) + 32 * hh) * N + n0 + nn);
    }
    for (int par = 0; unit < tiles; unit += G, par ^= 1) {
        bf16_t* t = (bf16_t*)ldsc + par * (64 * 72);
        const int k0 = (unit / tilesN) * 64, n0 = (unit % tilesN) * 64;
#pragma unroll
        for (int hh = 0; hh < 2; ++hh) {
            const int kk = ((tid >> 4) + 32 * hh + 8 * (tid & 15)) & 63;
            t[(nn + 0) * 72 + kk] = f2bf(v[hh][0]); t[(nn + 1) * 72 + kk] = f2bf(v[hh][1]); t[(nn + 2) * 72 + kk] = f2bf(v[hh][2]); t[(nn + 3) * 72 + kk] = f2bf(v[hh][3]);
        }
        if (unit + G < tiles) {
            const int un = unit + G, k1 = (un / tilesN) * 64, n1 = (un % tilesN) * 64;
#pragma unroll
            for (int hh = 0; hh < 2; ++hh) v[hh] = *(const f32x4*)(W + (size_t)(k1 + (tid >> 4) + 32 * hh) * N + n1 + nn);
        }
        __syncthreads();
        { const int n = tid >> 3, k8 = (tid & 7) * 8; int nr = n0 + n;
          if (permk && nr >= EI && nr < 2 * EI) { const int cl = nr & 255; nr = (nr & ~255) + ((cl >> 5) & 1) * 128 + (cl >> 6) * 32 + (cl & 31); }
          *(u32x4*)(Wt + (size_t)nr * K + k0 + k8) = *(const u32x4*)(t + n * 72 + ((k8 + 8 * (n >> 2)) & 63)); }
    }
    __syncthreads();
}

template <class Epi>
__device__ void gemm_bt(int wid_s, int bid_opaque, const bf16_t* A, const bf16_t* Bt, int M, int N, int K, const Epi& epi, char* lds) {
    PHASE_IDS;
    constexpr int RS = 144;
    constexpr int TB = 128 * RS;
    const int tid = TIDX, lane = tid & 63, w = tid >> 6, wm = w >> 1, wn = w & 1;
    const int ldrow = tid >> 2, ldc = (tid & 3) * 2;
    const int tilesN = N / 128, nunits = (M / 128) * tilesN, nk = K / 64;
    for (int unit = BIDX; unit < nunits; unit += gridDim.x) {
        const int m0 = (unit / tilesN) * 128, n0 = (unit % tilesN) * 128;
        const bf16_t* ga = A + (size_t)(m0 + ldrow) * K + ldc * 8;
        const bf16_t* gb = Bt + (size_t)(n0 + ldrow) * K + ldc * 8;
        f32x4 acc[2][4];
#pragma unroll
        for (int i = 0; i < 2; ++i)
#pragma unroll
            for (int j = 0; j < 4; ++j) acc[i][j] = (f32x4){0.f, 0.f, 0.f, 0.f};
        u32x4 ra0 = *(const u32x4*)ga, ra1 = *(const u32x4*)(ga + 8), rb0 = *(const u32x4*)gb, rb1 = *(const u32x4*)(gb + 8);
        {
            char* sa = lds + ldrow * RS + ldc * 16; char* sb = lds + TB + ldrow * RS + ldc * 16;
            *(u32x4*)sa = ra0; *(u32x4*)(sa + 16) = ra1; *(u32x4*)sb = rb0; *(u32x4*)(sb + 16) = rb1;
        }
        __syncthreads();
        for (int kt = 0; kt < nk; ++kt) {
            const int cur = kt & 1;
            if (kt + 1 < nk) { const bf16_t* a2 = ga + (kt + 1) * 64; const bf16_t* b2 = gb + (kt + 1) * 64; ra0 = *(const u32x4*)a2; ra1 = *(const u32x4*)(a2 + 8); rb0 = *(const u32x4*)b2; rb1 = *(const u32x4*)(b2 + 8); }
            const char* sA = lds + cur * 2 * TB; const char* sB = sA + TB;
#pragma unroll
            for (int ks = 0; ks < 2; ++ks) {
                bf16x8 af[2], bfr[4];
#pragma unroll
                for (int mt = 0; mt < 2; ++mt) af[mt] = *(const bf16x8*)(sA + (wm * 32 + mt * 16 + (lane & 15)) * RS + ks * 64 + (lane >> 4) * 16);
#pragma unroll
                for (int nt = 0; nt < 4; ++nt) bfr[nt] = *(const bf16x8*)(sB + (wn * 64 + nt * 16 + (lane & 15)) * RS + ks * 64 + (lane >> 4) * 16);
#pragma unroll
                for (int mt = 0; mt < 2; ++mt)
#pragma unroll
                    for (int nt = 0; nt < 4; ++nt) acc[mt][nt] = MFMA16(bfr[nt], af[mt], acc[mt][nt]);
            }
            if (kt + 1 < nk) {
                char* sa = lds + (cur ^ 1) * 2 * TB + ldrow * RS + ldc * 16; char* sb = sa + TB;
                *(u32x4*)sa = ra0; *(u32x4*)(sa + 16) = ra1; *(u32x4*)sb = rb0; *(u32x4*)(sb + 16) = rb1;
            }
            __syncthreads();
        }
#pragma unroll
        for (int mt = 0; mt < 2; ++mt)
#pragma unroll
            for (int nt = 0; nt < 4; ++nt) epi(m0 + wm * 32 + mt * 16 + (lane & 15), n0 + wn * 64 + nt * 16 + (lane >> 4) * 4, acc[mt][nt]);
    }
}

namespace pg8 {
#define PG8_LAS __attribute__((address_space(3)))
typedef unsigned short bf16_t;
typedef short bf16x8 __attribute__((ext_vector_type(8)));
typedef float f32x4 __attribute__((ext_vector_type(4)));
typedef unsigned u32x4 __attribute__((ext_vector_type(4)));
constexpr int BM = 256, BK = 64, HALF = 128, HTB = HALF * BK * 2  , STAGE_BYTES = 8 * HTB, NXCD = 8, WGM = 4;

__host__ __device__ __forceinline__ int lds_byte(int r, int c) { const int st = (r >> 4) * 2 + (c >> 5), rr = r & 15, cc = c & 31, ob = rr * 64 + cc * 2; return st * 1024 + (ob ^ (((ob >> 9) & 1) << 5)); }
__host__ __device__ __forceinline__ void stage_rc(int b, int& R, int& C) { const int st = b / 1024, sb = b % 1024, swz = sb ^ (((sb >> 9) & 1) << 5); R = (st >> 1) * 16 + swz / 64; C = (st & 1) * 32 + (swz % 64) / 2; }
__host__ __device__ __forceinline__ int perm32(int rho) { const int n = rho >> 4, i = rho & 15; return 8 * (i >> 2) + 4 * n + (i & 3); }

struct Unit { int pm, pn; };
struct Gemm { const bf16_t* A; const bf16_t* Bt; int M, N, K; };

struct StaticOrder {
    int nM, nN, nwg, G, c, c0 = 0, skipctx = 0;
    __host__ __device__ void init(int M, int N, int G_, int c_, int c0_ = 0) { nM = M / BM; nN = N / BM; nwg = nM * nN; G = G_; c = c_; c0 = c0_; }
    __host__ __device__ bool next(int i, Unit& u) const {
        const int nfull = nwg / G;
        long L;
        if (c0 == 0 || i < nfull) L = (long)i * G + c;
        else { if (c < c0) return false; L = (long)nfull * G + (c - c0) + (long)(G - c0) * (i - nfull); }
        if (L >= nwg) return false;
        int wgid = (int)L; { const int q = nwg / NXCD, r = nwg % NXCD, xcd = wgid % NXCD, off = wgid / NXCD; wgid = (xcd < r ? xcd * (q + 1) : r * (q + 1) + (xcd - r) * q) + off; }
        const int nig = WGM * nN, gid = wgid / nig, fm = gid * WGM, gsz = (nM - fm) < WGM ? (nM - fm) : WGM;
        u.pm = fm + ((wgid % nig) % gsz); u.pn = (wgid % nig) / gsz; if (skipctx) u.pm += u.pm >> 3; return true;
    }
    __device__ __forceinline__ void a_ready(const Unit&) const {}
    __device__ __forceinline__ void done(const Unit&) const {}
};

__device__ __forceinline__ unsigned cvt_pk_bf16(float lo, float hi) { unsigned r; asm volatile("v_cvt_pk_bf16_f32 %0, %1, %2" : "=v"(r) : "v"(lo), "v"(hi)); return r; }
typedef float f32x2 __attribute__((ext_vector_type(2)));
template <class Epi, class Sched, bool ALIGN_EPI = false, bool SP2 = false>
__device__ __forceinline__ void gemm_phase(PG8_LAS unsigned char* lds, const Gemm g, const Sched& S, const Epi& E, const int tid, const int wid) {
    const int lane = tid & 63, wr = wid >> 2, wc = wid & 3, fr = lane & 15, fq = lane >> 4;
    const int K = g.K, nt = K / BK;
    unsigned voffA[2], voffB[2];
#pragma unroll
    for (int i = 0; i < 2; ++i) { int R, C; stage_rc(tid * 16 + i * 8192, R, C); const int Rb = Epi::PERM ? ((R & ~31) + perm32(R & 31)) : R;
        voffA[i] = (unsigned)(R * K + C) * 2u; voffB[i] = (unsigned)(Rb * K + C) * 2u; }
    const size_t kstep = (size_t)(BK * 2);
    const size_t hstep = (size_t)HALF * K * 2;
    const size_t tstep = 2 * hstep;
    const unsigned ldsw = (unsigned)wid * 1024u;
    const int aoff = lds_byte(wr * 64 + fr, fq * 8), boff = lds_byte(wc * 32 + fr, fq * 8);
#define PG8_SA(b, h) (((b) * 2 + (h)) * HTB)
#define PG8_SB(b, h) ((4 + (b) * 2 + (h)) * HTB)
#define PG8_STAGE(bufoff, gbase, voff) do { _Pragma("unroll") for (int _i = 0; _i < 2; ++_i) \
        __builtin_amdgcn_global_load_lds((const unsigned*)((const char*)(gbase) + (voff)[_i]), (PG8_LAS unsigned*)(lds + (bufoff) + ldsw + _i * 8192), 16, 0, 0); } while (0)
#define PG8_LDA(dst, b, h) do { _Pragma("unroll") for (int m = 0; m < 4; ++m) _Pragma("unroll") for (int k = 0; k < 2; ++k) dst[m][k] = *(const PG8_LAS bf16x8*)(lds + PG8_SA(b, h) + aoff + m * 2048 + k * 1024); } while (0)
#define PG8_LDB(dst, b, h) do { _Pragma("unroll") for (int n = 0; n < 2; ++n) _Pragma("unroll") for (int k = 0; k < 2; ++k) dst[n][k] = *(const PG8_LAS bf16x8*)(lds + PG8_SB(b, h) + boff + n * 2048 + k * 1024); } while (0)
#define PG8_MMA(ai, bj, At, Bt) do { __builtin_amdgcn_s_setprio(1); _Pragma("unroll") for (int m = 0; m < 4; ++m) _Pragma("unroll") for (int n = 0; n < 2; ++n) _Pragma("unroll") for (int k = 0; k < 2; ++k) \
        acc[ai][bj][m][n] = __builtin_amdgcn_mfma_f32_16x16x32_bf16(Bt[n][k], At[m][k], acc[ai][bj][m][n], 0, 0, 0); __builtin_amdgcn_s_setprio(0); } while (0)
#define PG8_WAIT_V(n) asm volatile("s_waitcnt vmcnt(" #n ")" ::: "memory")
#define PG8_WAIT_L(n) asm volatile("s_waitcnt lgkmcnt(" #n ")" ::: "memory")
#define PG8_BAR __builtin_amdgcn_s_barrier()
#define PG8_SCHED __builtin_amdgcn_sched_barrier(0)
    Unit cur, nxt; int ui = 0;
    if (!S.next(0, cur)) return;
    f32x4 acc[2][2][4][2];
#pragma unroll
    for (int a = 0; a < 2; ++a)
#pragma unroll
        for (int b = 0; b < 2; ++b)
#pragma unroll
            for (int m = 0; m < 4; ++m)
#pragma unroll
                for (int n = 0; n < 2; ++n) acc[a][b][m][n] = (f32x4){0.f, 0.f, 0.f, 0.f};
    bf16x8 At[4][2], B0[2][2], B1[2][2];
    const char* cA = (const char*)g.A + (size_t)cur.pm * tstep; const char* cB = (const char*)g.Bt + (size_t)cur.pn * tstep;
    S.a_ready(cur);
    if constexpr (SP2) {
        PG8_STAGE(PG8_SB(0, 0), cB, voffB); PG8_STAGE(PG8_SB(0, 1), cB + hstep, voffB); PG8_STAGE(PG8_SA(0, 0), cA, voffA); PG8_STAGE(PG8_SA(0, 1), cA + hstep, voffA);
        if (wr == 1) PG8_BAR;
        PG8_WAIT_V(2); PG8_BAR;
        PG8_STAGE(PG8_SB(1, 0), cB + kstep, voffB); PG8_STAGE(PG8_SA(1, 0), cA + kstep, voffA); PG8_STAGE(PG8_SB(1, 1), cB + hstep + kstep, voffB);
        PG8_WAIT_V(6); PG8_BAR;
    } else {
        PG8_STAGE(PG8_SB(0, 0), cB, voffB); PG8_STAGE(PG8_SA(0, 0), cA, voffA); PG8_STAGE(PG8_SB(0, 1), cB + hstep, voffB); PG8_STAGE(PG8_SA(0, 1), cA + hstep, voffA);
        if (wr == 1) PG8_BAR;
        PG8_WAIT_V(4); PG8_BAR;
        PG8_STAGE(PG8_SB(1, 0), cB + kstep, voffB); PG8_STAGE(PG8_SA(1, 0), cA + kstep, voffA); PG8_STAGE(PG8_SB(1, 1), cB + hstep + kstep, voffB);
        PG8_WAIT_V(6); PG8_BAR;
    }
    for (;;) {
        const bool has_next = S.next(ui + 1, nxt);
        const char* nA = has_next ? (const char*)g.A + (size_t)nxt.pm * tstep : cA; const char* nB = has_next ? (const char*)g.Bt + (size_t)nxt.pn * tstep : cB;
        for (int t = 0; t < nt; t += 2) {
            const bool last = (t == nt - 2);
            const char* a1 = cA + (size_t)(t + 1) * kstep;
            const char* a2 = last ? nA : cA + (size_t)(t + 2) * kstep; const char* b2 = last ? nB : cB + (size_t)(t + 2) * kstep;
            const char* a3 = a2 + kstep; const char* b3 = b2 + kstep;
            if (last && has_next) S.a_ready(nxt);
            if constexpr (SP2) {
            PG8_LDB(B0, 0, 0); PG8_LDB(B1, 0, 1); PG8_SCHED; PG8_LDA(At, 0, 0); PG8_STAGE(PG8_SA(1, 1), a1 + hstep, voffA);
            PG8_WAIT_V(8); PG8_WAIT_L(0); PG8_BAR; PG8_MMA(0, 0, At, B0); PG8_MMA(0, 1, At, B1); PG8_BAR; PG8_SCHED;
            PG8_LDA(At, 0, 1); PG8_STAGE(PG8_SB(0, 0), b2, voffB); PG8_STAGE(PG8_SB(0, 1), b2 + hstep, voffB); PG8_STAGE(PG8_SA(0, 0), a2, voffA);
            PG8_WAIT_V(8); PG8_WAIT_L(0); PG8_BAR; PG8_MMA(1, 0, At, B0); PG8_MMA(1, 1, At, B1); PG8_BAR; PG8_SCHED;
            PG8_LDB(B0, 1, 0); PG8_LDB(B1, 1, 1); PG8_SCHED; PG8_LDA(At, 1, 0); PG8_STAGE(PG8_SA(0, 1), a2 + hstep, voffA);
            PG8_WAIT_V(8); PG8_WAIT_L(0); PG8_BAR; PG8_MMA(0, 0, At, B0); PG8_MMA(0, 1, At, B1); PG8_BAR; PG8_SCHED;
            PG8_LDA(At, 1, 1); PG8_STAGE(PG8_SB(1, 0), b3, voffB); PG8_STAGE(PG8_SB(1, 1), b3 + hstep, voffB); PG8_STAGE(PG8_SA(1, 0), a3, voffA);
            PG8_WAIT_V(8); PG8_WAIT_L(0); PG8_BAR; PG8_MMA(1, 0, At, B0); PG8_MMA(1, 1, At, B1); PG8_BAR; PG8_SCHED;
            } else {
            PG8_LDB(B0, 0, 0); PG8_SCHED; PG8_LDA(At, 0, 0); PG8_STAGE(PG8_SA(1, 1), a1 + hstep, voffA);
            PG8_WAIT_L(8); PG8_BAR; PG8_WAIT_L(0); PG8_MMA(0, 0, At, B0); PG8_BAR; PG8_SCHED;
            PG8_LDB(B1, 0, 1); PG8_STAGE(PG8_SB(0, 0), b2, voffB);
            PG8_BAR; PG8_WAIT_L(0); PG8_MMA(0, 1, At, B1); PG8_BAR;
            PG8_LDA(At, 0, 1); PG8_STAGE(PG8_SA(0, 0), a2, voffA);
            PG8_BAR; PG8_WAIT_L(0); PG8_MMA(1, 0, At, B0); PG8_BAR; PG8_SCHED;
            PG8_STAGE(PG8_SB(0, 1), b2 + hstep, voffB);
            PG8_WAIT_V(6); PG8_BAR; PG8_MMA(1, 1, At, B1); PG8_BAR;
            PG8_LDB(B0, 1, 0); PG8_SCHED; PG8_LDA(At, 1, 0); PG8_STAGE(PG8_SA(0, 1), a2 + hstep, voffA);
            PG8_WAIT_L(8); PG8_BAR; PG8_WAIT_L(0); PG8_MMA(0, 0, At, B0); PG8_BAR; PG8_SCHED;
            PG8_LDB(B1, 1, 1); PG8_STAGE(PG8_SB(1, 0), b3, voffB);
            PG8_BAR; PG8_WAIT_L(0); PG8_MMA(0, 1, At, B1); PG8_BAR;
            PG8_LDA(At, 1, 1); PG8_STAGE(PG8_SA(1, 0), a3, voffA);
            PG8_BAR; PG8_WAIT_L(0); PG8_MMA(1, 0, At, B0); PG8_BAR; PG8_SCHED;
            PG8_STAGE(PG8_SB(1, 1), b3 + hstep, voffB);
            PG8_WAIT_V(6); PG8_BAR; PG8_MMA(1, 1, At, B1); PG8_BAR;
            }
        }
        if constexpr (ALIGN_EPI) { if (wr == 0) PG8_BAR; }
        if constexpr (!Epi::AFTER_DRAIN) { E(acc, cur, wr, wc, fr, fq); S.done(cur); }
        if (!has_next) break;
#pragma unroll
        for (int a = 0; a < 2; ++a)
#pragma unroll
            for (int b = 0; b < 2; ++b)
#pragma unroll
                for (int m = 0; m < 4; ++m)
#pragma unroll
                    for (int n = 0; n < 2; ++n) acc[a][b][m][n] = (f32x4){0.f, 0.f, 0.f, 0.f};
        cur = nxt; cA = nA; cB = nB; ++ui;
        if constexpr (ALIGN_EPI) { if (wr == 1) PG8_BAR; }
    }
    PG8_WAIT_V(0);
    if constexpr (!ALIGN_EPI) { if (wr == 0) PG8_BAR; }
    PG8_BAR;
    if constexpr (Epi::AFTER_DRAIN) { E.fused(acc, cur, wr, wc, fr, fq, lds, wid, lane); S.done(cur); }
#undef PG8_SA
#undef PG8_SB
#undef PG8_STAGE
#undef PG8_LDA
#undef PG8_LDB
#undef PG8_MMA
#undef PG8_WAIT_V
#undef PG8_WAIT_L
#undef PG8_BAR
#undef PG8_SCHED
}
}

template <class F> struct EpiAdapt {
    static constexpr bool PERM = true, AFTER_DRAIN = false; F f;
    DI void operator()(const f32x4 (&acc)[2][2][4][2], const pg8::Unit& u, int wr, int wc, int fr, int fq) const {
#pragma unroll
        for (int ai = 0; ai < 2; ++ai)
#pragma unroll
            for (int m = 0; m < 4; ++m) {
                const int row = u.pm * 256 + ai * 128 + wr * 64 + m * 16 + fr;
#pragma unroll
                for (int bj = 0; bj < 2; ++bj) { const int col = u.pn * 256 + bj * 128 + wc * 32 + 8 * fq; f.store8(row, col, acc[ai][bj][m][0], acc[ai][bj][m][1]); }
            }
    }
};
template <class F>
__device__ void gemm_pg8(int wid_s, int bid_opaque, const bf16_t* A, const bf16_t* Bt, int M, int N, int K, const F& f, char* lds, int c0 = 0, int skipctx = 0) {
    PHASE_IDS;
    pg8::StaticOrder S; S.init(M, N, (int)gridDim.x, BIDX, c0); S.skipctx = skipctx;
    const pg8::Gemm g{A, Bt, M, N, K};
    pg8::gemm_phase<EpiAdapt<F>, pg8::StaticOrder, true, true>((PG8_LAS unsigned char*)lds, g, S, EpiAdapt<F>{f}, TIDX, wid_s);
}

DI void sincos_rr(float x, float& s, float& c) {
    const float n = rintf(x * 0.15915494309f);
    float r = fmaf(-n, 6.2831855f, x); r = fmaf(-n, -1.7484555e-7f, r);
    s = __sinf(r); c = __cosf(r);
}
__device__ void qknorm_own_units(int wid_s, int bid_opaque, bf16_t* Q, bf16_t* K, const float* qg, const float* kg, int rope, char* lds, int c0 = 0) {
    PHASE_IDS;
    const int tid = TIDX, lane = tid & 63, w = wid_s, half = lane & 1;
    f32x2* tab = (f32x2*)lds;
    if (rope) for (int i = tid; i < 1024; i += NTHREADS) {
        const float inv = exp2f(-(float)(i & 15) * (13.287712379549449f / 16.f));
        float s, c; sincos_rr((float)(i >> 4) * inv, s, c); tab[i] = (f32x2){c, s};
    }
    asm volatile("s_waitcnt vmcnt(0)" ::: "memory");
    __syncthreads();
    pg8::StaticOrder S; S.init(GT, 4 * EI, (int)gridDim.x, BIDX, c0);
    pg8::Unit u;
    for (int ui = 0; S.next(ui, u); ++ui) {
        if (u.pn < 8 || u.pn >= 16) continue;
        bf16_t* B = (u.pn >> 3) ? K : Q;
        const float* g = ((u.pn >> 3) ? kg : qg) + half * 32;
        const int colbase = (u.pn & 7) * 256 + ((lane >> 1) & 3) * 64 + half * 32;
        u32x4 nxt[4];
        { const bf16_t* b0 = B + (size_t)(u.pm * 256 + w * 8 + (lane >> 3)) * EI + colbase;
#pragma unroll
          for (int i = 0; i < 4; ++i) nxt[i] = *(const u32x4*)(b0 + i * 8); }
#pragma unroll
        for (int it = w; it < 32; it += 8) {
            const int r = u.pm * 256 + it * 8 + (lane >> 3);
            bf16_t* base = B + (size_t)r * EI + colbase;
            u32x4 raw[4];
#pragma unroll
            for (int i = 0; i < 4; ++i) raw[i] = nxt[i];
            if (it + 8 < 32) {
#pragma unroll
                for (int i = 0; i < 4; ++i) nxt[i] = *(const u32x4*)(base + (size_t)64 * EI + i * 8);
            }
            float y[32]; float ss = 0.f;
#pragma unroll
            for (int i = 0; i < 4; ++i)
#pragma unroll
                for (int e = 0; e < 4; ++e) { y[i * 8 + 2 * e] = bflo(raw[i][e]); y[i * 8 + 2 * e + 1] = bfhi(raw[i][e]); }
#pragma unroll
            for (int d = 0; d < 32; ++d) ss += y[d] * y[d];
            ss += shx(ss, 1, lane);
            const float rstd = rsqrtf(ss * (1.f / 64.f) + EPS);
#pragma unroll
            for (int d = 0; d < 32; ++d) y[d] = y[d] * rstd * g[d];
            const int t = r % TPB;
            if (rope && t < SEQ) {
                const f32x2* cs = tab + (half ? (t & 63) : (t >> 6)) * 16;
#pragma unroll
                for (int i = 0; i < 16; ++i) {
                    const f32x2 v = cs[i];
                    const float a_ = y[i], b_ = y[i + 16];
                    y[i] = a_ * v[0] - b_ * v[1]; y[i + 16] = b_ * v[0] + a_ * v[1];
                }
            }
#pragma unroll
            for (int i = 0; i < 4; ++i) { u32x4 o;
#pragma unroll
                for (int e = 0; e < 4; ++e) o[e] = pack2(y[i * 8 + 2 * e], y[i * 8 + 2 * e + 1]);
                *(u32x4*)(base + i * 8) = o; }
        }
    }
}

struct EpiInProj {
    static constexpr bool PERM = true, AFTER_DRAIN = false;
    bf16_t* o0; const float* kg; const f32x2* tab; int rope;
    DI void operator()(const f32x4 (&acc)[2][2][4][2], const pg8::Unit& u, int wr, int wc, int fr, int fq) const {
        if ((u.pn >> 3) != 1) {
#pragma unroll
            for (int ai = 0; ai < 2; ++ai)
#pragma unroll
                for (int m = 0; m < 4; ++m) {
                    const int row = u.pm * 256 + ai * 128 + wr * 64 + m * 16 + fr;
#pragma unroll
                    for (int bj = 0; bj < 2; ++bj) {
                        const int col = u.pn * 256 + bj * 128 + wc * 32 + 8 * fq;
                        const f32x4 a = acc[ai][bj][m][0], b = acc[ai][bj][m][1];
                        u32x4 r; r[0] = pack2(a[0], a[1]); r[1] = pack2(a[2], a[3]); r[2] = pack2(b[0], b[1]); r[3] = pack2(b[2], b[3]);
                        *(u32x4*)(o0 + (size_t)(col >> 11) * BUFE + (size_t)row * EI + (col & 2047)) = r;
                    }
                }
            return;
        }
        const int lane = fq * 16 + fr;
        const bool lat = (u.pm % 9) != 8;
        const float sgn = fq < 2 ? -1.f : 1.f;
        f32x4 g[2][2];
#pragma unroll
        for (int bj = 0; bj < 2; ++bj) { g[bj][0] = *(const f32x4*)(kg + bj * 32 + 8 * fq); g[bj][1] = *(const f32x4*)(kg + bj * 32 + 8 * fq + 4); }
        bf16_t* const kout = o0 + BUFE;
#pragma unroll
        for (int ai = 0; ai < 2; ++ai)
#pragma unroll
            for (int m = 0; m < 4; ++m) {
                const int row = u.pm * 256 + ai * 128 + wr * 64 + m * 16 + fr;
                float y[2][8]; float ss = 0.f;
#pragma unroll
                for (int bj = 0; bj < 2; ++bj)
#pragma unroll
                    for (int j = 0; j < 8; ++j) { y[bj][j] = acc[ai][bj][m][j >> 2][j & 3]; ss += y[bj][j] * y[bj][j]; }
                ss += shx(ss, 16, lane); ss += shx(ss, 32, lane);
                const float rstd = rsqrtf(ss * (1.f / 64.f) + EPS);
#pragma unroll
                for (int bj = 0; bj < 2; ++bj)
#pragma unroll
                    for (int j = 0; j < 8; ++j) y[bj][j] = y[bj][j] * rstd * g[bj][j >> 2][j & 3];
                if (rope && lat) {
                    const int t = row % TPB;
#pragma unroll
                    for (int bj = 0; bj < 2; ++bj) {
                        const f32x2* cs = tab + (bj ? (t & 63) : (t >> 6)) * 16 + 8 * (fq & 1);
#pragma unroll
                        for (int j = 0; j < 8; ++j) { const f32x2 v = cs[j]; const float other = shx(y[bj][j], 32, lane); y[bj][j] = y[bj][j] * v[0] + sgn * other * v[1]; }
                    }
                }
#pragma unroll
                for (int bj = 0; bj < 2; ++bj) {
                    const int col = (u.pn & 7) * 256 + wc * 64 + bj * 32 + 8 * fq;
                    u32x4 r; r[0] = pack2(y[bj][0], y[bj][1]); r[1] = pack2(y[bj][2], y[bj][3]); r[2] = pack2(y[bj][4], y[bj][5]); r[3] = pack2(y[bj][6], y[bj][7]);
                    *(u32x4*)(kout + (size_t)row * EI + col) = r;
                }
            }
    }
};
struct EpiBf16 {
    bf16_t* out; int ld; float scale;
    DI void operator()(int row, int col, f32x4 v) const { u32x2 o; o[0] = pack2(v[0] * scale, v[1] * scale); o[1] = pack2(v[2] * scale, v[3] * scale); *(u32x2*)(out + (size_t)row * ld + col) = o; }
    DI void store8(int row, int col, f32x4 a, f32x4 b) const { u32x4 o; o[0] = pack2(a[0] * scale, a[1] * scale); o[1] = pack2(a[2] * scale, a[3] * scale); o[2] = pack2(b[0] * scale, b[1] * scale); o[3] = pack2(b[2] * scale, b[3] * scale); *(u32x4*)(out + (size_t)row * ld + col) = o; }
};
struct EpiResid {
    ResidPtrs rp; int layer; int row_off; int lat_only;
    DI void operator()(int row, int col, f32x4 v) const {
        const int R = row_off + row; int mvi;
        const int b = R / TPB, t = R - b * TPB;
        if (lat_only && t >= SEQ) return;
        const float* src = resid_ptr(rp, R, mvi);
        float* dst = (t < SEQ) ? rp.out + ((size_t)b * SEQ + t) * DM : rp.hctx + ((size_t)b * CTXL + (t - SEQ)) * DM;
        const f32x4 g = *(const f32x4*)(rp.mod + (layer * 9 + mvi) * 3072 + 2048 + col);
        const f32x4 base = *(const f32x4*)(src + col);
        f32x4 o;
#pragma unroll
        for (int e = 0; e < 4; ++e) o[e] = base[e] + g[e] * v[e];
        *(f32x4*)(dst + col) = o;
    }
    DI void store8(int row, int col, f32x4 a, f32x4 b) const { (*this)(row, col, a); (*this)(row, col + 4, b); }
};

#define LAS __attribute__((address_space(3)))
typedef __attribute__((address_space(3))) bf16x4 lds_bf16x4;
DI bf16x4 tr_read(const char* p) { return __builtin_amdgcn_ds_read_tr16_b64_v4i16((lds_bf16x4*)p); }
DI void qnorm_frag(const u32x4 (&raw)[4], const float* gq, const f32x2* tab, int t, bool rope, float c, int lane_, bf16x8 (&qf)[4]) {
    const int h = lane_ >> 5;
    float y[4][8]; float ss = 0.f;
#pragma unroll
    for (int s = 0; s < 4; ++s)
#pragma unroll
        for (int e = 0; e < 4; ++e) { y[s][2 * e] = bflo(raw[s][e]); y[s][2 * e + 1] = bfhi(raw[s][e]); ss += y[s][2 * e] * y[s][2 * e] + y[s][2 * e + 1] * y[s][2 * e + 1]; }
    ss += shx(ss, 32, lane_);
    const float rstd = rsqrtf(ss * (1.f / 64.f) + EPS);
#pragma unroll
    for (int s = 0; s < 4; ++s) {
        const f32x4 g0 = *(const f32x4*)(gq + s * 16 + h * 8), g1 = *(const f32x4*)(gq + s * 16 + h * 8 + 4);
#pragma unroll
        for (int j = 0; j < 8; ++j) y[s][j] = y[s][j] * rstd * (j < 4 ? g0[j & 3] : g1[j & 3]);
    }
    if (rope) {
#pragma unroll
        for (int hf = 0; hf < 2; ++hf) {
            const f32x2* cs = tab + (hf ? (t & 63) : (t >> 6)) * 16 + h * 8;
#pragma unroll
            for (int j = 0; j < 8; ++j) {
                const f32x2 v = cs[j];
                const float a_ = y[2 * hf][j], b_ = y[2 * hf + 1][j];
                y[2 * hf][j] = a_ * v[0] - b_ * v[1]; y[2 * hf + 1][j] = b_ * v[0] + a_ * v[1];
            }
        }
    }
#pragma unroll
    for (int s = 0; s < 4; ++s) {
        u32x4 o;
#pragma unroll
        for (int e = 0; e < 4; ++e) o[e] = pack2(y[s][2 * e] * c, y[s][2 * e + 1] * c);
        qf[s] = __builtin_bit_cast(bf16x8, o);
    }
}
DI void rope_table(f32x2* tab, int tid) {
    for (int i = tid; i < 1024; i += NTHREADS) {
        const float inv = exp2f(-(float)(i & 15) * (13.287712379549449f / 16.f));
        float s, c; sincos_rr((float)(i >> 4) * inv, s, c); tab[i] = (f32x2){c, s};
    }
}
__device__ void phase_inproj_ab(int wid_s, int bid_opaque, const bf16_t* A, const bf16_t* Bt, bf16_t* o0, const float* kg, int rope, char* lds, int c0) {
    PHASE_IDS;
    f32x2* tab = (f32x2*)(lds + 131072);
    if (rope) rope_table(tab, TIDX);
    __syncthreads();
    pg8::StaticOrder S; S.init(GT, 4 * EI, (int)gridDim.x, BIDX, c0);
    const pg8::Gemm g{A, Bt, GT, 4 * EI, DM};
    pg8::gemm_phase<EpiInProj, pg8::StaticOrder, true, true>((PG8_LAS unsigned char*)lds, g, S, EpiInProj{o0, kg, tab, rope}, TIDX, wid_s);
}
template <bool SHIFT>
__device__ void phase_attn_a(int wid_s, int bid_opaque, const Params& p, int layer, int j, int need_ctx, char* lds) {
    PHASE_IDS;
    const int tid = TIDX, lane = tid & 63, w = wid_s, sub = w >> 2, qg = w & 3;
    const bf16_t* Q = PBUF(0); const bf16_t* Kb = PBUF(1); const bf16_t* Vb = PBUF(2); const bf16_t* Z = PBUF(3); bf16_t* Y = PBUF(4);
    const float* lv = PF(a_lam) + j * 256;
    const float d1 = wave_sum(lv[lane] * lv[64 + lane], lane), d2 = wave_sum(lv[128 + lane] * lv[192 + lane], lane);
    const float lam_init = 0.8f - 0.6f * expf(-0.3f * (float)layer);
    const float lam = expf(d1) - expf(d2) + lam_init;
    const float gqm = wave_max(fabsf(PF(a_qn_g)[j * 64 + lane]), lane), gkm = wave_max(fabsf(PF(a_kn_g)[j * 64 + lane]), lane);
    const float c1 = 0.125f * 1.4426950408889634f, c2 = 8.f * gqm * gkm * 1.4426950408889634f;
    const float* sg = PF(a_subln_g) + j * 128;
    const float* gqn = PF(a_qn_g) + j * 64;
    f32x2* rtab = (f32x2*)(lds + 132096);
    rope_table(rtab, tid);
    __syncthreads();
    const int nlat = GB * 16 * 16, nunits = nlat + (need_ctx ? GB * 16 * 2 : 0);
    for (int ubase = 0; ubase < nunits; ubase += 256) {
        const int unit = gridDim.x == 256 ? xcd_unit(ubase, BIDX) : ubase + BIDX;
        if (unit >= nunits || (gridDim.x != 256 && BIDX >= 256)) continue;
        int bl, vh, q0, kt0, nkt;
        if (unit < nlat) { bl = unit >> 8; vh = (unit >> 4) & 15; q0 = (unit & 15) * 128 + qg * 32; kt0 = 0; nkt = TPB / 128; }
        else { const int u2 = unit - nlat; bl = u2 >> 5; vh = (u2 >> 1) & 15; q0 = SEQ + (u2 & 1) * 128 + qg * 32; kt0 = SEQ / 128; nkt = CTXL / 128; }
        bf16x8 qf[4];
        {
            const int lane_ = launder(lane), li = lane_ & 31, h = lane_ >> 5;
            u32x4 raw[4];
#pragma unroll
            for (int s = 0; s < 4; ++s) raw[s] = *(const u32x4*)(Q + ((size_t)(bl * TPB + q0 + li)) * EI + vh * 128 + sub * 64 + s * 16 + h * 8);
            qnorm_frag(raw, gqn, rtab, q0 + li, q0 < SEQ, c1, lane_, qf);
        }
        const bf16_t* kgbase = Kb + ((size_t)(bl * TPB + kt0 * 128)) * EI + vh * 128;
        const bf16_t* vgbase = Vb + ((size_t)(bl * TPB + kt0 * 128)) * EI + vh * 128;
#define ATT_STAGE(buf, tile, ln) do { const int srow_ = (ln) >> 4, spos_ = (ln) & 15; const size_t to_ = (size_t)(tile) * 128 * EI; LAS char* lb_ = (LAS char*)(lds) + (buf) * 65536 + w * 4096; \
            _Pragma("unroll") for (int pc_ = 0; pc_ < 4; ++pc_) { const int r_ = 16 * w + 4 * pc_ + srow_; \
                __builtin_amdgcn_global_load_lds((const unsigned*)(kgbase + to_ + (unsigned)(r_ * EI + ((spos_ ^ (r_ & 15)) << 3))), (LAS unsigned*)(lb_ + pc_ * 1024), 16, 0, 0); \
                __builtin_amdgcn_global_load_lds((const unsigned*)(vgbase + to_ + (unsigned)(r_ * EI + ((spos_ ^ ((r_ & 3) << 2)) << 3))), (LAS unsigned*)(lb_ + 32768 + pc_ * 1024), 16, 0, 0); } } while (0)
        ATT_STAGE(0, 0, launder(lane));
        __syncthreads();
        f32x16 O[4];
#pragma unroll
        for (int d = 0; d < 4; ++d) O[d] = zero16();
        float l = 0.f;
        for (int it = 0; it < nkt; ++it) {
            const int lane_ = launder(lane), li = lane_ & 31, h = lane_ >> 5;
            const char* kvb = lds + (it & 1) * 65536;
            if (it + 1 < nkt) ATT_STAGE((it + 1) & 1, it + 1, lane_);
            const int g_ = lane_ >> 4, i_ = lane_ & 15, vq = i_ >> 2, vp = i_ & 3;
            const char* vrd = kvb + 32768 + (4 * h + vq) * 256 + (vp & 1) * 8;
            const int vch = 2 * (g_ & 1) + (vp >> 1), vsw = vq << 2, dsw = 2 * sub;
            bf16x8 kfr[2][4]; bf16x4 vt[2][4][4];
#define ATT_LOADK(set, kb_) do { const int krow_ = (kb_) * 32 + li; const char* krd_ = kvb + krow_ * 256; const int ksw_ = krow_ & 15; \
                _Pragma("unroll") for (int s = 0; s < 4; ++s) kfr[set][s] = *(const bf16x8*)(krd_ + (((8 * sub + 2 * s + h) ^ ksw_) << 4)); } while (0)
#define ATT_LOADV(set, kb_) do { _Pragma("unroll") for (int d = 0; d < 4; ++d) { const char* va_ = vrd + ((kb_) * 32) * 256 + (((4 * (d ^ dsw) + vch) ^ vsw) << 4); \
                    _Pragma("unroll") for (int q8 = 0; q8 < 4; ++q8) vt[set][d][q8] = tr_read(va_ + q8 * 8 * 256); } } while (0)
            ATT_LOADK(0, 0); ATT_LOADK(1, 1); ATT_LOADV(0, 0);
            f32x16 Sc = zero16();
#pragma unroll
            for (int s = 0; s < 4; ++s) Sc = MFMA32(kfr[0][s], qf[s], Sc);
#pragma unroll
            for (int kb = 0; kb < 4; ++kb) {
                f32x16 Sn = zero16();
                if (kb + 1 < 4) {
#pragma unroll
                    for (int s = 0; s < 4; ++s) Sn = MFMA32(kfr[(kb + 1) & 1][s], qf[s], Sn);
                }
                if (kb + 2 < 4) { if (kb & 1) ATT_LOADK(1, kb + 2); else ATT_LOADK(0, kb + 2); }
                if (kb + 1 < 4) { if (kb & 1) ATT_LOADV(0, kb + 1); else ATT_LOADV(1, kb + 1); }
                float ps = 0.f;
#pragma unroll
                for (int r = 0; r < 16; ++r) { const float e = __builtin_amdgcn_exp2f(SHIFT ? Sc[r] - c2 : Sc[r]); Sc[r] = e; ps += e; }
                l += ps;
                const bf16x8 pf0 = pack_acc(Sc, 0), pf1 = pack_acc(Sc, 1);
#pragma unroll
                for (int d = 0; d < 4; ++d) {
                    O[d] = MFMA32(cat4(vt[kb & 1][d][0], vt[kb & 1][d][1]), pf0, O[d]);
                    O[d] = MFMA32(cat4(vt[kb & 1][d][2], vt[kb & 1][d][3]), pf1, O[d]);
                }
                Sc = Sn;
            }
            __syncthreads();
        }
        const int lane_e = launder(lane), li = lane_e & 31, h = lane_e >> 5;
        float* xch = (float*)lds + qg * 4096 + lane_e * 4;
        float* ssx = (float*)lds + 4 * 4096 + qg * 64;
        l += shx(l, 32, lane_e);
        const float inv = (sub == 1 ? lam : 1.f) / l;
        const int dsw_e = 2 * sub;
#pragma unroll
        for (int dd_ = 0; dd_ < 2; ++dd_) {
            const int d = (2 + dd_) ^ dsw_e;
#pragma unroll
            for (int r4 = 0; r4 < 4; ++r4)
                *(f32x4*)(xch + (d * 4 + r4) * 256) = (f32x4){O[2 + dd_][4 * r4] * inv, O[2 + dd_][4 * r4 + 1] * inv, O[2 + dd_][4 * r4 + 2] * inv, O[2 + dd_][4 * r4 + 3] * inv};
        }
        __syncthreads();
        {
            const size_t qoff = ((size_t)(bl * TPB + q0 + li)) * EI + vh * 128;
            const float sgn = sub == 0 ? 1.f : -1.f;
            float ss = 0.f;
#pragma unroll
            for (int dd_ = 0; dd_ < 2; ++dd_) {
                const int d = dd_ ^ dsw_e;
#pragma unroll
                for (int r4 = 0; r4 < 4; ++r4) {
                    const f32x4 xo = *(const f32x4*)(xch + (d * 4 + r4) * 256);
#pragma unroll
                    for (int e = 0; e < 4; ++e) { const float o = sgn * (O[dd_][4 * r4 + e] * inv - xo[e]); O[dd_][4 * r4 + e] = o; ss += o * o; }
                }
            }
            ss += shx(ss, 32, lane_e);
            if (h == 0) ssx[sub * 32 + li] = ss;
            __syncthreads();
            ss += ssx[(sub ^ 1) * 32 + li];
            const float rs = rsqrtf(ss * (1.f / 128.f) + EPS) * (1.f - lam_init);
#pragma unroll
            for (int dd_ = 0; dd_ < 2; ++dd_) {
                const int d = dd_ ^ dsw_e;
#pragma unroll
                for (int g4 = 0; g4 < 4; ++g4) {
                    const int dd = d * 32 + 8 * g4 + 4 * h;
                    const u32x2 zr = *(const u32x2*)(Z + qoff + dd);
                    const f32x4 sgv = *(const f32x4*)(sg + dd);
                    const float z0 = bflo(zr[0]), z1 = bfhi(zr[0]), z2 = bflo(zr[1]), z3 = bfhi(zr[1]);
                    u32x2 o;
                    o[0] = pack2(O[dd_][4 * g4 + 0] * rs * sgv[0] * silu_f(z0), O[dd_][4 * g4 + 1] * rs * sgv[1] * silu_f(z1));
                    o[1] = pack2(O[dd_][4 * g4 + 2] * rs * sgv[2] * silu_f(z2), O[dd_][4 * g4 + 3] * rs * sgv[3] * silu_f(z3));
                    *(u32x2*)(Y + qoff + dd) = o;
                }
            }
        }
        __syncthreads();
    }
}

DI void glds16(const void* g, unsigned lds_base) {
    unsigned sv; asm volatile("s_mov_b32 %0, m0\n\ts_mov_b32 m0, %2\n\ts_nop 0\n\tglobal_load_lds_dwordx4 %1, off\n\ts_mov_b32 m0, %0" : "=&s"(sv) : "v"(g), "s"(lds_base) : "memory"); }
#define NAT_FENCE() asm volatile("" ::: "memory")
template <bool LAT, int QB, int KB>
DI void nat_bias(const char* brow, const unsigned (&bo4)[4], float (&bias)[16]) {
#pragma unroll
    for (int r = 0; r < 16; ++r) {
        const bool maybe = LAT && ((QB == KB) || (QB == 0 ? r < 4 : r >= 12));
        if (maybe) { unsigned b4 = bo4[r >> 2]; asm volatile("" : "+v"(b4)); bias[r] = *(const float*)(brow + ((b4 >> (8 * (r & 3))) & 0xffu)); }
        else bias[r] = 0.f;
    }
}
template <bool LAT, int QB, int KB>
DI float nat_exps(f32x16& S, const float (&bias)[16], float c2) {
    const float L2E = 1.4426950408889634f;
    float ps = 0.f;
#pragma unroll
    for (int r = 0; r < 16; ++r) {
        const bool maybe = !LAT || (QB == KB) || (QB == 0 ? r < 4 : r >= 12);
        float e = 0.f;
        if (maybe) e = __builtin_amdgcn_exp2f(S[r] * (0.125f * L2E) + (LAT ? bias[r] : -c2));
        S[r] = e; ps += e;
    }
    return ps;
}
template <bool LAT>
DI void nat_tile(const char* kvb, const char* brow, float c2, const bf16x8 (&qf)[2][4], const unsigned (&boff)[2][2][4], f32x16 (&O)[2][2], float (&l)[2], int lane_) {
    const int li = lane_ & 31, h = lane_ >> 5;
    const int g_ = lane_ >> 4, i_ = lane_ & 15, vq = i_ >> 2, vp = i_ & 3;
    const char* vrd = kvb + 8192 + (4 * h + vq) * 128 + (vp & 1) * 8;
    const int vch = 2 * (g_ & 1) + (vp >> 1), vsw = (vq >> 1) << 2;
    const char* krd0 = kvb + li * 128; const int ksw = li & 7;
    bf16x8 kf0[4], kf1[4], vt[2][2];
    float bA[16], bB[16];
    f32x16 Sa, Sb;
    bf16x8 pa[2], pb[2];
#pragma unroll
    for (int s = 0; s < 4; ++s) kf0[s] = *(const bf16x8*)(krd0 + (((2 * s + h) ^ ksw) << 4));
    nat_bias<LAT, 0, 0>(brow, boff[0][0], bA);
    NAT_FENCE();
    Sa = zero16(); Sb = zero16();
#pragma unroll
    for (int s = 0; s < 4; ++s) Sa = MFMA32(kf0[s], qf[0][s], Sa);
#pragma unroll
    for (int s = 0; s < 4; ++s) Sb = MFMA32(kf0[s], qf[1][s], Sb);
#pragma unroll
    for (int s = 0; s < 4; ++s) kf1[s] = *(const bf16x8*)(krd0 + 32 * 128 + (((2 * s + h) ^ ksw) << 4));
    nat_bias<LAT, 1, 0>(brow, boff[1][0], bB);
#pragma unroll
    for (int d = 0; d < 2; ++d)
#pragma unroll
        for (int s = 0; s < 2; ++s) { const char* va = vrd + (16 * s) * 128 + (((4 * d + vch) ^ vsw) << 4); vt[d][s] = cat4(tr_read(va), tr_read(va + 8 * 128)); }
    NAT_FENCE();
    l[0] += nat_exps<LAT, 0, 0>(Sa, bA, c2); pa[0] = pack_acc(Sa, 0); pa[1] = pack_acc(Sa, 1);
    nat_bias<LAT, 0, 1>(brow, boff[0][1], bA);
    Sa = zero16();
#pragma unroll
    for (int s = 0; s < 4; ++s) Sa = MFMA32(kf1[s], qf[0][s], Sa);
    NAT_FENCE();
    l[1] += nat_exps<LAT, 1, 0>(Sb, bB, c2); if (!LAT) pb[0] = pack_acc(Sb, 0); pb[1] = pack_acc(Sb, 1);
    nat_bias<LAT, 1, 1>(brow, boff[1][1], bB);
    Sb = zero16();
#pragma unroll
    for (int s = 0; s < 4; ++s) Sb = MFMA32(kf1[s], qf[1][s], Sb);
#pragma unroll
    for (int d = 0; d < 2; ++d) {
        O[0][d] = MFMA32(vt[d][0], pa[0], O[0][d]); O[0][d] = MFMA32(vt[d][1], pa[1], O[0][d]);
        if (!LAT) O[1][d] = MFMA32(vt[d][0], pb[0], O[1][d]);
        O[1][d] = MFMA32(vt[d][1], pb[1], O[1][d]);
    }
#pragma unroll
    for (int d = 0; d < 2; ++d)
#pragma unroll
        for (int s = 0; s < 2; ++s) { const char* va = vrd + (32 + 16 * s) * 128 + (((4 * d + vch) ^ vsw) << 4); vt[d][s] = cat4(tr_read(va), tr_read(va + 8 * 128)); }
    NAT_FENCE();
    l[0] += nat_exps<LAT, 0, 1>(Sa, bA, c2); pa[0] = pack_acc(Sa, 0); if (!LAT) pa[1] = pack_acc(Sa, 1);
    l[1] += nat_exps<LAT, 1, 1>(Sb, bB, c2); pb[0] = pack_acc(Sb, 0); pb[1] = pack_acc(Sb, 1);
#pragma unroll
    for (int d = 0; d < 2; ++d) {
        O[0][d] = MFMA32(vt[d][0], pa[0], O[0][d]);
        if (!LAT) O[0][d] = MFMA32(vt[d][1], pa[1], O[0][d]);
        O[1][d] = MFMA32(vt[d][0], pb[0], O[1][d]); O[1][d] = MFMA32(vt[d][1], pb[1], O[1][d]);
    }
}

__device__ void phase_attn_b(int wid_s, int bid_opaque, const Params& p, int need_ctx, char* lds) {
    PHASE_IDS;
    const float* const rpb_g = PF(b_rpb);
    const int tid = TIDX, lane = tid & 63, w = wid_s;
    const bf16_t* Q = PBUF(0); const bf16_t* Kb = PBUF(1); const bf16_t* Vb = PBUF(2); const bf16_t* Z = PBUF(3); bf16_t* Y = PBUF(4);
    const unsigned lbase = (unsigned)(size_t)(LAS char*)lds;
    const float gqm = wave_max(fabsf(PF(b_qn_g)[lane]), lane), gkm = wave_max(fabsf(PF(b_kn_g)[lane]), lane);
    const float L2E = 1.4426950408889634f;
    float* rpb_s = (float*)(lds + 65536);
    unsigned boff[2][2][4];
    {
        const int li = lane & 31, h = lane >> 5;
#pragma unroll
        for (int qb = 0; qb < 2; ++qb)
#pragma unroll
            for (int kb = 0; kb < 2; ++kb)
#pragma unroll
                for (int r4 = 0; r4 < 4; ++r4) {
                    unsigned pk = 0;
#pragma unroll
                    for (int e = 0; e < 4; ++e) {
                        const int r = 4 * r4 + e, qc = 32 * qb + li, ws = min(max(qc - 8, 0), 48), kc = kb * 32 + (r & 3) + 8 * (r >> 2) + 4 * h;
                        const bool valid = (kc >= ws) && (kc < ws + 16);
                        pk |= (unsigned)((valid ? (kc - qc + 15) : 31) * 4) << (8 * e);
                    }
                    boff[qb][kb][r4] = pk;
                }
    }
    const int nlat = GB * 32 * 4, nunits = nlat + (need_ctx ? GB * 32 : 0);
    for (int ubase = 0; ubase < nunits; ubase += 256) {
        const int unit = gridDim.x == 256 ? xcd_unit(ubase, BIDX) : ubase + BIDX;
        if (unit >= nunits || (gridDim.x != 256 && BIDX >= 256)) continue;
        int bl, head, rg = 0; bool isctx;
        if (unit < nlat) { bl = unit >> 7; head = (unit >> 2) & 31; rg = unit & 3; isctx = false; }
        else { const int u2 = unit - nlat; bl = u2 >> 5; head = u2 & 31; isctx = true; }
        const int row = 8 * rg + w;
        const int q0 = isctx ? SEQ + 64 * (w & 3) : row * 64;
        const int rs = min(max(row - 4, 0), 24);
        const int krlo = isctx ? 0 : min(max(8 * rg - 4, 0), 24), krhi = isctx ? -1 : min(max(8 * rg + 3, 0), 24) + 7;
        const int nlt = krhi - krlo + 1, nt = nlt + 4;
        float bm = 0.f;
        const int tid_u = launder(tid), lane_u = tid_u & 63;
        for (int i = lane_u; i < 465; i += 64) bm = fmaxf(bm, fabsf(rpb_g[head * 465 + i]));
        bm = wave_max(bm, lane_u);
        const float c2 = (8.f * gqm * gkm + bm) * L2E;
        if (tid_u < 480) { const int rr = tid_u >> 5, cc = tid_u & 31; rpb_s[tid_u] = cc < 31 ? rpb_g[head * 465 + rr * 31 + cc] * L2E - c2 : -1e30f; }
        bf16x8 qf[2][4];
        {
            const int lane_q = launder(lane), li = lane_q & 31, h = lane_q >> 5;
#pragma unroll
            for (int qb = 0; qb < 2; ++qb) {
                u32x4 raw[4];
#pragma unroll
                for (int s = 0; s < 4; ++s) raw[s] = *(const u32x4*)(Q + ((size_t)(bl * TPB + q0 + 32 * qb + li)) * EI + head * 64 + s * 16 + h * 8);
                qnorm_frag(raw, PF(b_qn_g), (const f32x2*)nullptr, 0, false, 1.f, lane_q, qf[qb]);
            }
        }
        const bf16_t* kbase = Kb + (size_t)bl * TPB * EI + head * 64;
        const bf16_t* vbase = Vb + (size_t)bl * TPB * EI + head * 64;
#define NAT_TOK(t_) ((t_) < nlt ? (krlo + (t_)) * 64 : SEQ + ((t_) - nlt) * 64)
#define NAT_ISSUE(t_) do { const int ti_ = (t_) < nt ? (t_) : nt - 1; const int ln_ = launder(lane), r_ = 8 * w + (ln_ >> 3), c_ = ln_ & 7; const size_t ro_ = (size_t)(NAT_TOK(ti_) + r_) * EI; \
            const unsigned sl_ = lbase + (unsigned)(((t_) & 3) * 16384 + w * 1024); \
            glds16(kbase + ro_ + ((c_ ^ (r_ & 7)) << 3), sl_); glds16(vbase + ro_ + ((c_ ^ (((r_ >> 1) & 1) << 2)) << 3), sl_ + 8192u); } while (0)
#pragma unroll
        for (int qb = 0; qb < 2; ++qb)
#pragma unroll
            for (int s = 0; s < 4; ++s) asm volatile("" : "+v"(qf[qb][s]));
        NAT_ISSUE(0); NAT_ISSUE(1); NAT_ISSUE(2);
        f32x16 O[2][2];
#pragma unroll
        for (int a_ = 0; a_ < 2; ++a_) { O[a_][0] = zero16(); O[a_][1] = zero16(); }
        float l[2] = {0.f, 0.f};
        for (int it = 0; it < nt; ++it) {
            asm volatile("s_waitcnt vmcnt(4) lgkmcnt(0)\n\ts_barrier" ::: "memory");
            NAT_ISSUE(it + 3);
            const int lane_ = launder(lane);
            const char* kvb = lds + (it & 3) * 16384;
            const int kr = krlo + it;
            if (it < nlt) { if (kr >= rs && kr < rs + 8) nat_tile<true>(kvb, (const char*)(rpb_s + (kr - row + 7) * 32), c2, qf, boff, O, l, lane_); }
            else nat_tile<false>(kvb, (const char*)rpb_s, c2, qf, boff, O, l, lane_);
        }
        asm volatile("s_waitcnt vmcnt(0)" ::: "memory");
        if (!(isctx && w >= 4)) {
            const int lane_e = launder(lane), li = lane_e & 31, h = lane_e >> 5;
#pragma unroll
            for (int qb = 0; qb < 2; ++qb) {
                float lt = l[qb]; lt += shx(lt, 32, lane_e);
                const float il = 1.f / lt;
                const size_t qoff = ((size_t)(bl * TPB + q0 + 32 * qb + li)) * EI + head * 64;
#pragma unroll
                for (int d = 0; d < 2; ++d)
#pragma unroll
                    for (int g4 = 0; g4 < 4; ++g4) {
                        const int dd = d * 32 + 8 * g4 + 4 * h;
                        const u32x2 zr = *(const u32x2*)(Z + qoff + dd);
                        u32x2 o;
                        o[0] = pack2(O[qb][d][4 * g4 + 0] * il * silu_f(bflo(zr[0])), O[qb][d][4 * g4 + 1] * il * silu_f(bfhi(zr[0])));
                        o[1] = pack2(O[qb][d][4 * g4 + 2] * il * silu_f(bflo(zr[1])), O[qb][d][4 * g4 + 3] * il * silu_f(bfhi(zr[1])));
                        *(u32x2*)(Y + qoff + dd) = o;
                    }
            }
        }
        __syncthreads();
    }
}

DI int chunk_tok0(int cidx) { return cidx < 32 ? cidx * 64 : SEQ + (cidx - 32) * 64; }

__device__ void phase_c_pre(int wid_s, int bid_opaque, const Params& p, int g_, char* lds) {
    PHASE_IDS;
    const float* const conv_b = PF(c_conv_b); const float* const conv_w = PF(c_conv_w);
    const float* const wq_p = PF(c_wq); const float* const wk_p = PF(c_wk); const float* const wv_p = PF(c_wv);
    const bf16_t* const gwt = PF(gwt); float* const gates_o = PF(gates); float* const sbuf_o = PF(sbuf);
    constexpr int XS = 272;
    char* xs = lds;
    char* qs = lds + 18432;
    char* ks = qs + 64 * XS;
    char* vs = ks + 64 * XS;
    float* red = (float*)(vs + 64 * XS);
    const int w = wid_s;
    const bf16_t* XM = PBUF(0); bf16_t* Qf = PBUF(1); bf16_t* KTf = PBUF(2);
    const float kscale = 0.04419417382415922f;
    const int nunits = GB * NCHUNK * 4, G = (int)gridDim.x;
    const bool bal = G == 256;
    const int nsteps = bal ? 9 : (BIDX < nunits ? 4 * ((nunits - BIDX + G - 1) / G) : 0);
    float* const Sp = (float*)(PF(u) + (size_t)(1 - g_) * GT * DM);
    float* const Gp = Sp + 64 * 4 * 4096;
    u32x4 xv[3]; f32x4 cbv, cw[4], wqm[4], wkm[4], wvm[4]; bf16x8 gb[6];
#define CPRE_UNIT(step_) (bal ? ((step_) < 8 ? BIDX + ((step_) >> 2) * 256 : 512 + (BIDX >> 2)) : BIDX + ((step_) >> 2) * G)
#define CPRE_CC(step_) (bal && (step_) >= 8 ? (BIDX & 3) : ((step_) & 3))
#define CPRE_DECODE(step_) const int un_ = CPRE_UNIT(step_), cc_ = CPRE_CC(step_), hd_ = un_ & 3, ci_ = (un_ >> 2) % NCHUNK, bl_ = un_ / (4 * NCHUNK), colb_ = hd_ * 512 + cc_ * 128
#define CPRE_LOADX(step_) do { CPRE_DECODE(step_); const int tid_ = FRESH_TID(); const int tk_ = chunk_tok0(ci_), lo_ = ci_ < 32 ? 0 : SEQ, hi_ = ci_ < 32 ? SEQ : TPB; \
        _Pragma("unroll") for (int i_ = 0; i_ < 3; ++i_) { const int ch_ = tid_ + i_ * NTHREADS, rr_ = ch_ >> 4, c16_ = ch_ & 15, tt_ = tk_ - 2 + rr_; \
            xv[i_] = (u32x4){0u, 0u, 0u, 0u}; if (ch_ < 67 * 16 && tt_ >= lo_ && tt_ < hi_) xv[i_] = *(const u32x4*)(XM + ((size_t)(bl_ * TPB + tt_)) * EI + colb_ + c16_ * 8); } } while (0)
#define CPRE_LOADW(step_) do { CPRE_DECODE(step_); const int nb_ = FRESH_TID() & 31, col_ = colb_ + nb_ * 4, blk_ = col_ >> 2; cbv = *(const f32x4*)(conv_b + col_); \
        _Pragma("unroll") for (int jj = 0; jj < 4; ++jj) { cw[jj] = *(const f32x4*)(conv_w + jj * EI + col_); wqm[jj] = *(const f32x4*)(wq_p + blk_ * 16 + jj * 4); \
            wkm[jj] = *(const f32x4*)(wk_p + blk_ * 16 + jj * 4); wvm[jj] = *(const f32x4*)(wv_p + blk_ * 16 + jj * 4); } } while (0)
#define CPRE_LOADG(step_) do { CPRE_DECODE(step_); const int ln_ = fresh_lane(), r16_ = ln_ & 15, kq_ = ln_ >> 4; \
        _Pragma("unroll") for (int k6 = 0; k6 < 6; ++k6) { const int kk = 6 * (w >> 2) + k6, part = kk >> 2, k32 = kk & 3; \
            gb[k6] = *(const bf16x8*)(gwt + (size_t)r16_ * 6144 + part * 2048 + colb_ + k32 * 32 + kq_ * 8); } } while (0)
    if (nsteps > 0) { CPRE_LOADX(0); CPRE_LOADW(0); CPRE_LOADG(0); }
    f32x4 Sacc[2] = {{0.f, 0.f, 0.f, 0.f}, {0.f, 0.f, 0.f, 0.f}};
    f32x4 Gacc = {0.f, 0.f, 0.f, 0.f};
    for (int step = 0; step < nsteps; ++step) {
        const int unit = CPRE_UNIT(step), cc = CPRE_CC(step);
        const bool part = bal && step >= 8;
        const int head = unit & 3, cidx = (unit >> 2) % NCHUNK, bl = unit / (4 * NCHUNK);
        const int tok0 = chunk_tok0(cidx);
        const size_t cb = (size_t)(bl * 4 + head) * NCHUNK + cidx;
        {
            const int lane = fresh_lane(), tid = w * 64 + lane;
#pragma unroll
            for (int i = 0; i < 3; ++i) { const int ch = tid + i * NTHREADS; if (ch < 67 * 16) *(u32x4*)(xs + (ch >> 4) * XS + (ch & 15) * 16) = xv[i]; }
            __syncthreads();
            if (step + 1 < nsteps) CPRE_LOADX(step + 1);
            const int nb = tid & 31, trow = tid >> 5;
#pragma unroll
            for (int i = 0; i < 4; ++i) {
                const int t = trow + 16 * i;
                f32x4 xr[4];
#pragma unroll
                for (int jj = 0; jj < 4; ++jj) { const u32x2 r2 = *(const u32x2*)(xs + (t + jj) * XS + nb * 8); xr[jj] = (f32x4){bflo(r2[0]), bfhi(r2[0]), bflo(r2[1]), bfhi(r2[1])}; }
                f32x4 xc = cbv;
#pragma unroll
                for (int jj = 0; jj < 4; ++jj) xc += cw[jj] * xr[jj];
#pragma unroll
                for (int e = 0; e < 4; ++e) xc[e] = silu_f(xc[e]);
                f32x4 qv = {0.f, 0.f, 0.f, 0.f}, kv = {0.f, 0.f, 0.f, 0.f}, vv = {0.f, 0.f, 0.f, 0.f};
#pragma unroll
                for (int d = 0; d < 4; ++d) { qv += xc[d] * wqm[d]; kv += xc[d] * wkm[d]; vv += xr[2][d] * wvm[d]; }
                kv *= kscale;
                u32x2 o;
                o[0] = pack2(qv[0], qv[1]); o[1] = pack2(qv[2], qv[3]); *(u32x2*)(qs + t * XS + nb * 8) = o;
                o[0] = pack2(kv[0], kv[1]); o[1] = pack2(kv[2], kv[3]); *(u32x2*)(ks + t * XS + nb * 8) = o;
                o[0] = pack2(vv[0], vv[1]); o[1] = pack2(vv[2], vv[3]); *(u32x2*)(vs + t * XS + nb * 8) = o;
            }
            __syncthreads();
            if (step + 1 < nsteps) CPRE_LOADW(step + 1);
            {
                const int tt = w >> 1, st0 = 2 * (w & 1), r16 = lane & 15, kq = lane >> 4;
#pragma unroll
                for (int kk = 0; kk < 4; ++kk) {
                    const bf16x8 a_ = *(const bf16x8*)(qs + (16 * tt + r16) * XS + kk * 64 + kq * 16);
                    Sacc[0] = MFMA16(a_, *(const bf16x8*)(ks + (16 * st0 + r16) * XS + kk * 64 + kq * 16), Sacc[0]);
                    Sacc[1] = MFMA16(a_, *(const bf16x8*)(ks + (16 * (st0 + 1) + r16) * XS + kk * 64 + kq * 16), Sacc[1]);
                }
                const int gt = w & 3;
#pragma unroll
                for (int k6 = 0; k6 < 6; ++k6) {
                    const int kk = 6 * (w >> 2) + k6, part = kk >> 2, k32 = kk & 3;
                    const char* tile = part == 0 ? qs : (part == 1 ? ks : vs);
                    const bf16x8 a_ = *(const bf16x8*)(tile + (16 * gt + r16) * XS + k32 * 64 + kq * 16);
                    Gacc = MFMA16(a_, gb[k6], Gacc);
                }
            }
            if (step + 1 < nsteps) CPRE_LOADG(step + 1);
            {
                bf16_t* qdst = Qf + (cb * 8 + 2 * cc) * 4096; bf16_t* kdst = KTf + (cb * 8 + 2 * cc) * 4096;
#pragma unroll
                for (int k2 = 0; k2 < 2; ++k2) {
                    const int f = w + 8 * k2, ksf = f & 3, tb = (f >> 2) & 1, ws2 = f >> 3;
                    const int li = lane & 31, h = lane >> 5;
                    const char* qa = qs + (32 * tb + li) * XS + (64 * ws2 + 32 * (ksf >> 1) + 16 * (ksf & 1) + 4 * h) * 2;
                    const u32x2 q0 = *(const u32x2*)qa, q1 = *(const u32x2*)(qa + 16);
                    *(u32x4*)(qdst + (size_t)f * 512 + lane * 8) = (u32x4){q0[0], q0[1], q1[0], q1[1]};
                    const int g = lane >> 4, i16 = lane & 15;
                    const char* ka = ks + (16 * ksf + 8 * (g >> 1) + (i16 >> 2)) * XS + (64 * ws2 + 32 * tb + 16 * (g & 1) + 4 * (i16 & 3)) * 2;
                    const bf16x4 k0 = tr_read(ka), k1 = tr_read(ka + 4 * XS);
                    *(bf16x8*)(kdst + (size_t)f * 512 + lane * 8) = cat4(k0, k1);
                }
            }
            __syncthreads();
        }
        if (part || cc == 3) {
            const int lane = fresh_lane(), r16 = lane & 15, kq = lane >> 4;
            {
                float* So = part ? Sp + (size_t)((unit - 512) * 4 + cc) * 4096 : sbuf_o + cb * 4096;
                const int tt = w >> 1, st0 = 2 * (w & 1);
#pragma unroll
                for (int j = 0; j < 2; ++j)
#pragma unroll
                    for (int r = 0; r < 4; ++r) So[(16 * tt + 4 * kq + r) * 64 + 16 * (st0 + j) + r16] = Sacc[j][r];
            }
#pragma unroll
            for (int r = 0; r < 4; ++r) red[((w >> 2) * 64 + 16 * (w & 3) + 4 * kq + r) * 16 + r16] = Gacc[r];
            __syncthreads();
            for (int o = w * 64 + lane; o < 1024; o += NTHREADS) {
                const int t = o >> 4, gi = o & 15;
                const float gsum = red[t * 16 + gi] + red[(64 + t) * 16 + gi];
                if (part) Gp[(size_t)((unit - 512) * 4 + cc) * 1024 + t * 16 + gi] = gsum; else gates_o[((size_t)(bl * TPB + tok0 + t) * 4 + head) * 16 + gi] = gsum;
            }
            __syncthreads();
            Sacc[0] = (f32x4){0.f, 0.f, 0.f, 0.f}; Sacc[1] = (f32x4){0.f, 0.f, 0.f, 0.f}; Gacc = (f32x4){0.f, 0.f, 0.f, 0.f};
        }
    }
}

__device__ void phase_gwt(int wid_s, int bid_opaque, const Params& p, int cu_lo = 0) {
    PHASE_IDS;
    if (BIDX < cu_lo) return;
    const float* gw = PF(c_gate_w); bf16_t* gwt = PF(gwt);
    for (int i = (BIDX - cu_lo) * NTHREADS + TIDX; i < 16 * 6144; i += ((int)gridDim.x - cu_lo) * NTHREADS) {
        const int n = i / 6144, col = i - n * 6144, dir = n >> 3, g = n & 7;
        float v = gw[((size_t)dir * 6144 + col) * 8 + g];
        if (col >= 2048 && col < 4096) v *= 22.627416997969522f;
        gwt[i] = f2bf(v);
    }
}

__device__ void phase_c_scan(int wid_s, int bid_opaque, const Params& p, int g_, char* lds) {
    PHASE_IDS;
    const auto c_gate_b_k = PF(c_gate_b);
    const auto c_wv_k = PF(c_wv);
    const auto gates_k = PF(gates);
    const auto sbuf_k = PF(sbuf);
    float* TAB = (float*)lds;
    char* PART = lds + 27648;
    float* DENP = (float*)(lds + 105984);
    char* WTS = lds + 108288;
    char* VTL = WTS + 9216;
    char* DVT0 = VTL + 13824;
    float* INTER0 = (float*)(DVT0 + 2 * 13824);
    float* EINV0 = INTER0 + 128;
    float* WVL = EINV0 + 128;
    const int tid0 = TIDX, w = wid_s;
    const bf16_t* XM = PBUF(0); const bf16_t* Q = PBUF(1); const bf16_t* KT = PBUF(2);
#define SCAN_LOADS(cx_, tid_) do { const int so_ = ((tid_) >> 3) * 64 + ((tid_) & 7) * 8; \
        if (bal && bl == 3 && (cx_) >= 20) { const float* pp_ = Sp + (size_t)(((cx_) - 20) * 4 + head) * 4 * 4096 + so_; \
            s0n = *(const f32x4*)pp_ + *(const f32x4*)(pp_ + 4096) + *(const f32x4*)(pp_ + 8192) + *(const f32x4*)(pp_ + 12288); \
            s1n = *(const f32x4*)(pp_ + 4) + *(const f32x4*)(pp_ + 4096 + 4) + *(const f32x4*)(pp_ + 8192 + 4) + *(const f32x4*)(pp_ + 12288 + 4); } \
        else { const float* sp_ = sbuf_k + ((size_t)((bl * 4 + head) * NCHUNK + (cx_))) * 4096 + so_; s0n = *(const f32x4*)sp_; s1n = *(const f32x4*)(sp_ + 4); } } while (0)
    const bool bal = gridDim.x == 256;
    const float* const Sp = (const float*)(PF(u) + (size_t)(1 - g_) * GT * DM);
    const float* const Gp = Sp + 64 * 4 * 4096;
    for (int ibase = 0; ibase < GB * 4 * 2 * 8; ibase += 256) {
        const int item = gridDim.x == 256 ? xcd_unit(ibase, BIDX) : ibase + BIDX;
        if (item >= GB * 4 * 2 * 8 || (gridDim.x != 256 && BIDX >= 256)) continue;
        const int eb = item & 7, dir = (item >> 3) & 1, head = (item >> 4) & 3, bl = item >> 6;
        bf16_t* H = PBUF(3 + dir);
        f32x16 Cacc[2][3];
#pragma unroll
        for (int a_ = 0; a_ < 2; ++a_)
#pragma unroll
            for (int b_ = 0; b_ < 3; ++b_) Cacc[a_][b_] = zero16();
        for (int i = tid0; i < 32 * 72; i += NTHREADS) {
            const int rr = 64 + i / 72, cc = i % 72;
            *(bf16_t*)(VTL + (rr * 72 + cc) * 2) = (rr == 64) ? (bf16_t)0x3F80 : (bf16_t)0;
            *(bf16_t*)(DVT0 + (rr * 72 + cc) * 2) = 0; *(bf16_t*)(DVT0 + 13824 + (rr * 72 + cc) * 2) = 0;
        }
        {
            const int lane = tid0 & 63, t = dir ? 63 - lane : lane;
            for (int st = w; st < NCHUNK; st += 8) {
                const int cidx = dir == 0 ? (st < 4 ? 32 + st : st - 4) : 35 - st;
                const size_t rb = (size_t)bl * TPB + chunk_tok0(cidx);
                const float* gp = gates_k + (rb + t) * 64 + dir * 8 + head;
                float pi = c_gate_b_k[dir * 8 + head], pf = c_gate_b_k[dir * 8 + 4 + head];
                if (bal && bl == 3 && cidx >= 20) {
                    for (int hq = 0; hq < 16; ++hq) { const float* gq_ = Gp + (size_t)((cidx - 20) * 16 + hq) * 1024 + t * 16 + dir * 8 + head; pi += gq_[0]; pf += gq_[4]; }
                } else {
#pragma unroll
                    for (int hh = 0; hh < 4; ++hh) { pi += gp[hh * 16]; pf += gp[hh * 16 + 4]; }
                }
                const float logf = fminf(pf, 0.f) - __logf(1.f + __expf(-fabsf(pf)));
                float bsum = logf;
#pragma unroll
                for (int o = 1; o < 64; o <<= 1) { const float v = shl_from(bsum, lane - o); if (lane >= o) bsum += v; }
                float pm = pi - bsum;
#pragma unroll
                for (int o = 1; o < 64; o <<= 1) { const float v = shl_from(pm, lane - o); if (lane >= o) pm = fmaxf(pm, v); }
                TAB[st * 192 + t] = bsum * 1.4426950408889634f; TAB[st * 192 + 64 + t] = pi * 1.4426950408889634f; TAB[st * 192 + 128 + t] = pm * 1.4426950408889634f;
            }
        }
        float m_prev = 0.f;
        float negm[8];
        { const int t = tid0 >> 3, s8 = (tid0 & 7) * 8;
#pragma unroll
          for (int e = 0; e < 8; ++e) { const int s = s8 + e; negm[e] = (dir ? (s >= t) : (s <= t)) ? 0.f : -1e30f; } }
        if (tid0 < 256) WVL[tid0] = c_wv_k[(size_t)((head * 512 + eb * 64) >> 2) * 16 + tid0];
        f32x4 s0n, s1n; u32x2 xmn[2];
        {
            const int tid = FRESH_TID(), lane = tid & 63;
            const int cidx = dir == 0 ? 32 : 35;
            const size_t rb = (size_t)bl * TPB + chunk_tok0(cidx);
            SCAN_LOADS(cidx, tid);
#pragma unroll
            for (int i = 0; i < 2; ++i) xmn[i] = *(const u32x2*)(XM + (rb + lane) * EI + head * 512 + eb * 64 + (w + 8 * i) * 4);
        }
        bf16x8 qf[2][4], kf[2][4];
        {
            const int lane = fresh_lane();
            const size_t fb = ((((size_t)(bl * 4 + head) * NCHUNK + (dir == 0 ? 32 : 35)) * 8 + w) * 8) * 512 + lane * 8;
#pragma unroll
            for (int f = 0; f < 8; ++f) { qf[f >> 2][f & 3] = *(const bf16x8*)(Q + fb + f * 512); kf[f >> 2][f & 3] = *(const bf16x8*)(KT + fb + f * 512); }
        }
        __syncthreads();
        for (int st = 0; st < NCHUNK; ++st) {
            const int lane = fresh_lane(), tid = w * 64 + lane, li = lane & 31, h = lane >> 5;
            const int cidx = dir == 0 ? (st < 4 ? 32 + st : st - 4) : 35 - st;
            const size_t rb = (size_t)bl * TPB + chunk_tok0(cidx);
            const float* tab = TAB + st * 192;
            char* DVT = DVT0 + (st & 1) * 13824; float* INTER = INTER0 + (st & 1) * 64; float* EINV = EINV0 + (st & 1) * 64;
            const int last = dir ? 0 : 63;
            const float b_last = tab[last], m_new = b_last + fmaxf(m_prev, tab[128 + last]);
            const float carry = __builtin_amdgcn_exp2f(b_last + m_prev - m_new);
            {
                const int t = tid >> 3, s8 = (tid & 7) * 8;
                const float bt = tab[t], mt = bt + fmaxf(m_prev, tab[128 + t]);
                const f32x4 tb0 = *(const f32x4*)(tab + s8), tb1 = *(const f32x4*)(tab + s8 + 4), ti0 = *(const f32x4*)(tab + 64 + s8), ti1 = *(const f32x4*)(tab + 64 + s8 + 4);
                float wv[8];
#pragma unroll
                for (int e = 0; e < 8; ++e) {
                    const float sv = e < 4 ? s0n[e & 3] : s1n[e & 3];
                    const float arg = (bt - mt + negm[e]) - (e < 4 ? tb0[e & 3] : tb1[e & 3]) + (e < 4 ? ti0[e & 3] : ti1[e & 3]);
                    wv[e] = __builtin_amdgcn_exp2f(arg) * sv;
                }
                u32x4 o; o[0] = pack2(wv[0], wv[1]); o[1] = pack2(wv[2], wv[3]); o[2] = pack2(wv[4], wv[5]); o[3] = pack2(wv[6], wv[7]);
                *(u32x4*)(WTS + t * 144 + s8 * 2) = o;
            }
            {
                const int s = lane;
                const float dc = __builtin_amdgcn_exp2f(b_last - tab[s] + tab[64 + s] - m_new);
#pragma unroll
                for (int i = 0; i < 2; ++i) {
                    const int nb = w + 8 * i;
                    f32x4 wvr[4];
#pragma unroll
                    for (int d = 0; d < 4; ++d) wvr[d] = *(const f32x4*)(WVL + nb * 16 + d * 4);
                    const float x0 = bflo(xmn[i][0]), x1 = bfhi(xmn[i][0]), x2 = bflo(xmn[i][1]), x3 = bfhi(xmn[i][1]);
#pragma unroll
                    for (int e = 0; e < 4; ++e) {
                        const float v = x0 * wvr[0][e] + x1 * wvr[1][e] + x2 * wvr[2][e] + x3 * wvr[3][e];
                        *(bf16_t*)(VTL + ((nb * 4 + e) * 72 + s) * 2) = f2bf(v);
                        *(bf16_t*)(DVT + ((nb * 4 + e) * 72 + s) * 2) = f2bf(v * dc);
                    }
                }
                if (w == 7) {
                    const float mt = tab[s] + fmaxf(m_prev, tab[128 + s]);
                    *(bf16_t*)(DVT + (64 * 72 + s) * 2) = f2bf(dc);
                    INTER[s] = __builtin_amdgcn_exp2f(tab[s] + m_prev - mt); EINV[s] = __builtin_amdgcn_exp2f(-mt);
                }
            }
            if (st + 1 < NCHUNK) {
                const int cn = dir == 0 ? (st + 1 < 4 ? 33 + st : st - 3) : 34 - st;
                const size_t rbn = (size_t)bl * TPB + chunk_tok0(cn);
                SCAN_LOADS(cn, tid);
#pragma unroll
                for (int i = 0; i < 2; ++i) xmn[i] = *(const u32x2*)(XM + (rbn + lane) * EI + head * 512 + eb * 64 + (w + 8 * i) * 4);
            }
            __syncthreads();
#pragma unroll
            for (int eo = 0; eo < 3; ++eo) {
                const int ebk = eo == 0 ? 2 : eo - 1;
                bf16x8 cf[4];
#pragma unroll
                for (int ks = 0; ks < 4; ++ks) cf[ks] = pack_acc(Cacc[ks >> 1][ebk], ks & 1);
#pragma unroll
                for (int tb = 0; tb < 2; ++tb) {
                    f32x16 P = zero16();
#pragma unroll
                    for (int ks = 0; ks < 4; ++ks) P = MFMA32(qf[tb][ks], cf[ks], P);
                    if (ebk == 2) {
                        if (li == 0) {
#pragma unroll
                            for (int g4 = 0; g4 < 4; ++g4) *(f32x4*)(DENP + w * 64 + 32 * tb + 8 * g4 + 4 * h) = (f32x4){P[4 * g4], P[4 * g4 + 1], P[4 * g4 + 2], P[4 * g4 + 3]};
                        }
                    } else {
#pragma unroll
                        for (int g4 = 0; g4 < 4; ++g4) {
                            u32x2 o; o[0] = pack2(P[4 * g4], P[4 * g4 + 1]); o[1] = pack2(P[4 * g4 + 2], P[4 * g4 + 3]);
                            *(u32x2*)(PART + (ebk * 9 + w) * 4352 + li * 136 + (32 * tb + 8 * g4 + 4 * h) * 2) = o;
                        }
                    }
                }
                if ((w >> 1) == ebk) {
                    const int hw = w & 1;
                    f32x16 P = zero16();
#pragma unroll
                    for (int ks = 0; ks < 4; ++ks) P = MFMA32(*(const bf16x8*)(WTS + (32 * hw + li) * 144 + ks * 32 + h * 16), *(const bf16x8*)(VTL + (32 * ebk + li) * 144 + ks * 32 + h * 16), P);
                    if (ebk == 2) {
                        if (li == 0) {
#pragma unroll
                            for (int g4 = 0; g4 < 4; ++g4) *(f32x4*)(DENP + 8 * 64 + 32 * hw + 8 * g4 + 4 * h) = (f32x4){P[4 * g4], P[4 * g4 + 1], P[4 * g4 + 2], P[4 * g4 + 3]};
                        }
                    } else {
#pragma unroll
                        for (int g4 = 0; g4 < 4; ++g4) {
                            u32x2 o; o[0] = pack2(P[4 * g4], P[4 * g4 + 1]); o[1] = pack2(P[4 * g4 + 2], P[4 * g4 + 3]);
                            *(u32x2*)(PART + (ebk * 9 + 8) * 4352 + li * 136 + (32 * hw + 8 * g4 + 4 * h) * 2) = o;
                        }
                    }
                }
            }
            const int cnext = dir == 0 ? (st + 1 < 4 ? 33 + st : st - 3) : 34 - st;
            const size_t fbn = ((((size_t)(bl * 4 + head) * NCHUNK + cnext) * 8 + w) * 8) * 512 + lane * 8;
            if (st + 1 < NCHUNK) {
#pragma unroll
                for (int f = 0; f < 8; ++f) qf[f >> 2][f & 3] = *(const bf16x8*)(Q + fbn + f * 512);
            }
            __syncthreads();
            {
                bf16x8 dvf[3][4];
#pragma unroll
                for (int ebk = 0; ebk < 3; ++ebk)
#pragma unroll
                    for (int ks = 0; ks < 4; ++ks) dvf[ebk][ks] = *(const bf16x8*)(DVT + (32 * ebk + li) * 144 + ks * 32 + h * 16);
                asm volatile("" ::: "memory");
#pragma unroll
                for (int db = 0; db < 2; ++db)
#pragma unroll
                    for (int ebk = 0; ebk < 3; ++ebk) {
#pragma unroll
                        for (int r = 0; r < 16; ++r) Cacc[db][ebk][r] *= carry;
                        mfma_c_pad(Cacc[db][ebk]);
#pragma unroll
                        for (int ks = 0; ks < 4; ++ks) Cacc[db][ebk] = MFMA32(kf[db][ks], dvf[ebk][ks], Cacc[db][ebk]);
                    }
            }
            {
                const int e = lane, t0 = 8 * w;
                float dq = DENP[(lane >> 3) * 64 + t0 + (lane & 7)];
                dq += shx(dq, 8, lane); dq += shx(dq, 16, lane); dq += shx(dq, 32, lane);
                const float it_l = INTER[t0 + (lane & 7)];
                const float den_l = it_l * dq + DENP[8 * 64 + t0 + (lane & 7)];
                const float rinv_l = __builtin_amdgcn_rcpf(fmaxf(fabsf(den_l), EINV[t0 + (lane & 7)]));
                float num[8];
#pragma unroll
                for (int jj = 0; jj < 8; ++jj) num[jj] = 0.f;
                const char* pbase = PART + ((e >> 5) * 9) * 4352 + (e & 31) * 136 + t0 * 2;
#pragma unroll
                for (int ww = 0; ww < 8; ++ww) {
                    const u32x2 pa = *(const u32x2*)(pbase + ww * 4352), pb = *(const u32x2*)(pbase + ww * 4352 + 8);
                    const u32x4 pv = {pa[0], pa[1], pb[0], pb[1]};
#pragma unroll
                    for (int q4 = 0; q4 < 4; ++q4) { num[2 * q4] += bflo(pv[q4]); num[2 * q4 + 1] += bfhi(pv[q4]); }
                }
                const u32x2 ia = *(const u32x2*)(pbase + 8 * 4352), ib = *(const u32x2*)(pbase + 8 * 4352 + 8);
                const u32x4 iv = {ia[0], ia[1], ib[0], ib[1]};
#pragma unroll
                for (int jj = 0; jj < 8; ++jj) {
                    const float itj = __uint_as_float((unsigned)__builtin_amdgcn_readlane((int)__float_as_uint(it_l), jj)), rj = __uint_as_float((unsigned)__builtin_amdgcn_readlane((int)__float_as_uint(rinv_l), jj));
                    const float intra = (jj & 1) ? bfhi(iv[jj >> 1]) : bflo(iv[jj >> 1]);
                    H[(rb + t0 + jj) * EI + head * 512 + eb * 64 + e] = f2bf((num[jj] * itj + intra) * rj);
                }
            }
            if (st + 1 < NCHUNK) {
#pragma unroll
                for (int f = 0; f < 8; ++f) kf[f >> 2][f & 3] = *(const bf16x8*)(KT + fbn + f * 512);
            }
            m_prev = m_new;
        }
    }
}

__device__ void phase_c_finish(int wid_s, int bid_opaque, const Params& p) {
    PHASE_IDS;
    const auto c_conv_b_k = PF(c_conv_b);
    const auto c_conv_w_k = PF(c_conv_w);
    const auto c_mhn_g_k = PF(c_mhn_g);
    const auto c_skip_k = PF(c_skip);
    const int tid = TIDX, lane = tid & 63;
    const int gw = BIDX * 8 + (tid >> 6), nw = gridDim.x * 8;
    const bf16_t* XM = PBUF(0); const bf16_t* Zb = PBUF(1); const bf16_t* OG = PBUF(2); const bf16_t* HF = PBUF(3); bf16_t* HB = PBUF(4);
    constexpr int RB = 18;
    for (int task = gw; task < (GT / RB) * 4; task += nw) {
        const int head = task & 3, r0 = (task >> 2) * RB;
        const int col = head * 512 + lane * 8;
        f32x4 cwv[4][2], cbv[2], gv[2], kv[2];
#pragma unroll
        for (int hh = 0; hh < 2; ++hh) {
            cbv[hh] = *(const f32x4*)(c_conv_b_k + col + 4 * hh); gv[hh] = *(const f32x4*)(c_mhn_g_k + col + 4 * hh); kv[hh] = *(const f32x4*)(c_skip_k + col + 4 * hh);
#pragma unroll
            for (int jj = 0; jj < 4; ++jj) cwv[jj][hh] = *(const f32x4*)(c_conv_w_k + jj * EI + col + 4 * hh);
        }
        u32x4 xw[4];
#pragma unroll
        for (int jj = 0; jj < 3; ++jj) { const int rr = r0 + jj - 2; xw[jj] = (rr >= 0) ? *(const u32x4*)(XM + (size_t)rr * EI + col) : (u32x4){0u, 0u, 0u, 0u}; }
        size_t off = (size_t)r0 * EI + col;
        u32x4 hf = *(const u32x4*)(HF + off), hb = *(const u32x4*)(HB + off), og = *(const u32x4*)(OG + off), zz = *(const u32x4*)(Zb + off);
        xw[3] = (r0 + 1 < GT) ? *(const u32x4*)(XM + (size_t)(r0 + 1) * EI + col) : (u32x4){0u, 0u, 0u, 0u};
#pragma unroll 2
        for (int i = 0; i < RB; ++i) {
            const int r = r0 + i, t = r % TPB;
            u32x4 hfn = hf, hbn = hb, ogn = og, zzn = zz, xn = {0u, 0u, 0u, 0u};
            if (i + 1 < RB) {
                const size_t offn = off + EI;
                hfn = *(const u32x4*)(HF + offn); hbn = *(const u32x4*)(HB + offn); ogn = *(const u32x4*)(OG + offn); zzn = *(const u32x4*)(Zb + offn);
                if (r + 2 < GT) xn = *(const u32x4*)(XM + (size_t)(r + 2) * EI + col);
            }
            float x[8]; float s = 0.f;
#pragma unroll
            for (int e = 0; e < 4; ++e) {
                x[2 * e] = (bflo(hf[e]) + bflo(hb[e])) * sigmoid_f(bflo(og[e]));
                x[2 * e + 1] = (bfhi(hf[e]) + bfhi(hb[e])) * sigmoid_f(bfhi(og[e]));
                s += x[2 * e] + x[2 * e + 1];
            }
            const float mu = wave_sum(s, lane) * (1.f / 512.f);
            float q = 0.f;
#pragma unroll
            for (int e = 0; e < 8; ++e) { const float d = x[e] - mu; q += d * d; }
            const float rstd = rsqrtf(wave_sum(q, lane) * (1.f / 512.f) + EPS);
            float xc[8];
#pragma unroll
            for (int e = 0; e < 4; ++e) { xc[e] = cbv[0][e]; xc[4 + e] = cbv[1][e]; }
            const int seq_lo = t < SEQ ? 0 : SEQ, seq_hi = t < SEQ ? SEQ : TPB;
#pragma unroll
            for (int jj = 0; jj < 4; ++jj) {
                const int tt = t + jj - 2;
                const float m = (tt >= seq_lo && tt < seq_hi) ? 1.f : 0.f;
#pragma unroll
                for (int e = 0; e < 4; ++e) {
                    const float lo = bflo(xw[jj][e]), hi = bfhi(xw[jj][e]);
                    const float wl = (2 * e < 4) ? cwv[jj][0][(2 * e) & 3] : cwv[jj][1][(2 * e) & 3], wh = (2 * e + 1 < 4) ? cwv[jj][0][(2 * e + 1) & 3] : cwv[jj][1][(2 * e + 1) & 3];
                    xc[2 * e] += wl * (m * lo); xc[2 * e + 1] += wh * (m * hi);
                }
            }
            float y[8];
#pragma unroll
            for (int e = 0; e < 8; ++e) {
                const float gg = e < 4 ? gv[0][e & 3] : gv[1][e & 3], kk = e < 4 ? kv[0][e & 3] : kv[1][e & 3];
                const float zv = (e & 1) ? bfhi(zz[e >> 1]) : bflo(zz[e >> 1]);
                y[e] = ((x[e] - mu) * rstd * gg + kk * silu_f(xc[e])) * silu_f(zv);
            }
            u32x4 o; o[0] = pack2(y[0], y[1]); o[1] = pack2(y[2], y[3]); o[2] = pack2(y[4], y[5]); o[3] = pack2(y[6], y[7]);
            *(u32x4*)(HB + off) = o;
            hf = hfn; hb = hbn; og = ogn; zz = zzn; xw[0] = xw[1]; xw[1] = xw[2]; xw[2] = xw[3]; xw[3] = xn; off += EI;
        }
    }
}

struct EpiBf16Split {
    bf16_t* o0; bf16_t* o1; int split; int ld;
    DI void operator()(int row, int col, f32x4 v) const {
        bf16_t* o = col < split ? o0 + col : o1 + (col - split);
        u32x2 r; r[0] = pack2(v[0], v[1]); r[1] = pack2(v[2], v[3]); *(u32x2*)(o + (size_t)row * ld) = r;
    }
    DI void store8(int row, int col, f32x4 a, f32x4 b) const {
        bf16_t* o = col < split ? o0 + col : o1 + (col - split);
        u32x4 r; r[0] = pack2(a[0], a[1]); r[1] = pack2(a[2], a[3]); r[2] = pack2(b[0], b[1]); r[3] = pack2(b[2], b[3]); *(u32x4*)(o + (size_t)row * ld) = r;
    }
};

struct EpiBf16Split4 {
    bf16_t* o0;
    DI void operator()(int row, int col, f32x4 v) const {
        u32x2 r; r[0] = pack2(v[0], v[1]); r[1] = pack2(v[2], v[3]); *(u32x2*)(o0 + (size_t)(col >> 11) * BUFE + (size_t)row * EI + (col & 2047)) = r;
    }
    DI void store8(int row, int col, f32x4 a, f32x4 b) const {
        u32x4 r; r[0] = pack2(a[0], a[1]); r[1] = pack2(a[2], a[3]); r[2] = pack2(b[0], b[1]); r[3] = pack2(b[2], b[3]); *(u32x4*)(o0 + (size_t)(col >> 11) * BUFE + (size_t)row * EI + (col & 2047)) = r;
    }
};

template <int KIND>
__device__ __forceinline__ void run_phase(const Params& p, int ph, char* lds, int wid_s) {
    const int bid_opaque = launder_s((int)__builtin_amdgcn_workgroup_id_x());
    const int code = PPROG(ph), kind = KIND >= 0 ? KIND : (code & 0xff), layer = (code >> 8) & 0xff, g = (code >> 16) & 0xff;
    const int type = layer % 3, j = layer / 3;
    const bf16_t* ug = PF(u) + (size_t)g * GT * DM;
    bf16_t* const winb = (layer & 1) ? PF(win2) : PF(win);
    const int lo_sel = (code >> 26) & 3, cu_lo = lo_sel == 0 ? 0 : lo_sel == 1 ? 64 : lo_sel == 2 ? 160 : 176;
    switch (kind) {
    case PH_MOD:
        phase_mod(wid_s, bid_opaque, p, lds);
        phase_wconv(wid_s, bid_opaque, PF(a_w_in), PF(win), DM, 4 * EI, lds, 0, 1);
        phase_wconv(wid_s, bid_opaque, PF(a_w_out), PF(wout), EI, DM, lds);
        break;
    case PH_NORM: phase_norm(wid_s, bid_opaque, p, layer, g, cu_lo); break;
    case PH_WCONV: {
        const float* wi = type == 0 ? PF(a_w_in) + (size_t)j * DM * 4 * EI : type == 1 ? PF(b_w_in) : PF(c_w_in);
        const float* wo = type == 0 ? PF(a_w_out) + (size_t)j * EI * DM : type == 1 ? PF(b_w_out) : PF(c_w_out);
        if (g == 0) { phase_wconv(wid_s, bid_opaque, wi, winb, DM, type == 2 ? 3 * EI : 4 * EI, lds, cu_lo, type != 2); if (type == 2) phase_gwt(wid_s, bid_opaque, p, cu_lo); }
        else phase_wconv(wid_s, bid_opaque, wo, PF(wout), EI, DM, lds, cu_lo);
    } break;
    case PH_AB_INPROJ: {
        const int c0 = (code >> 24) & 1 ? (layer == 3 && g == 1 ? 128 : 144) : 0;
        phase_inproj_ab(wid_s, bid_opaque, ug, winb, PBUF(0), type == 0 ? PF(a_kn_g) + j * 64 : PF(b_kn_g), type == 0, lds, c0);
    } break;
    case PH_A_ATTN: {
        float gq = 0.f, gk = 0.f;
        for (int i = 0; i < 64; ++i) { gq = fmaxf(gq, fabsf(PF(a_qn_g)[j * 64 + i])); gk = fmaxf(gk, fabsf(PF(a_kn_g)[j * 64 + i])); }
        if (8.f * gq * gk * 1.4426950408889634f > 100.f) phase_attn_a<true>(wid_s, bid_opaque, p, layer, j, layer < 3, lds);
        else phase_attn_a<false>(wid_s, bid_opaque, p, layer, j, layer < 3, lds);
    } break;
    case PH_B_ATTN: phase_attn_b(wid_s, bid_opaque, p, 1, lds); break;
    case PH_OUTPROJ: gemm_pg8(wid_s, bid_opaque, PBUF(4), PF(wout), layer == 3 ? GB * SEQ : GT, DM, EI, EpiResid{resid_ptrs(layer == 0), layer, g * GT, layer == 3}, lds, 0, layer == 3); break;
    case PH_C_INPROJ: gemm_pg8(wid_s, bid_opaque, ug, winb, GT, EI, DM, EpiBf16{PBUF(0), EI, 1.f}, lds, (code >> 24) & 1 ? 144 : 0); break;
    case PH_C_PRE: phase_c_pre(wid_s, bid_opaque, p, g, lds); break;
    case PH_C_SCAN: phase_c_scan(wid_s, bid_opaque, p, g, lds); break;
    case PH_C_ZOG: gemm_pg8(wid_s, bid_opaque, ug, winb + (size_t)EI * DM, GT, 2 * EI, DM, EpiBf16Split{PBUF(1), PBUF(2), EI, EI}, lds); break;
    case PH_C_FINISH: phase_c_finish(wid_s, bid_opaque, p); break;
    default: break;
    }
}

#if 1
#define XB_TMO      128
#define XB_XCNT(j)  (256  + 64 * (j))
#define XB_XSUB(j)  (1280 + 64 * (j))
#define XB_XGEN(j)  (2304 + 64 * (j))
#define XB_TOP      3328
#define XB_TOPGEN   3392
#define XCD_BAR_WORDS 3456
#define XB_SPIN_CAP (1u << 18)

__device__ __forceinline__ unsigned xb_ld(unsigned* p)              { return __hip_atomic_load(p, __ATOMIC_RELAXED, __HIP_MEMORY_SCOPE_AGENT); }
__device__ __forceinline__ unsigned xb_add(unsigned* p, unsigned v) { return __hip_atomic_fetch_add(p, v, __ATOMIC_RELAXED, __HIP_MEMORY_SCOPE_AGENT); }
__device__ __forceinline__ unsigned xb_xcc_id() { return (unsigned)__builtin_amdgcn_s_getreg((3 << 11) | 20) & 0xFu; }
#define XB_SPIN(cond, bar) do { unsigned _sp = 0; while (cond) { __builtin_amdgcn_s_sleep(1); \
    if ((++_sp & 255u) == 0u) { if (xb_ld(&(bar)[XB_TMO])) break; if (_sp > XB_SPIN_CAP) { atomicAdd(&(bar)[XB_TMO], 1u); break; } } } } while (0)

struct XcdBarrier {
    unsigned* bar; unsigned x;
    volatile LAS unsigned* st;
};

__device__ __forceinline__ XcdBarrier xcd_barrier_post(unsigned* bar, volatile LAS unsigned* st, bool leader) {
    XcdBarrier b; b.bar = bar; b.x = xb_xcc_id(); b.st = st;
    if (leader) (void)xb_add(&bar[XB_XCNT(b.x)], 1u);
    return b;
}
__device__ __forceinline__ void xcd_barrier_complete(unsigned* bar, unsigned x, unsigned& nloc, unsigned& nx) {
    const unsigned G = gridDim.x * gridDim.y * gridDim.z;
    unsigned sum, cnt, mine, sp = 0u;
    for (;;) {
        sum = 0u; cnt = 0u; mine = 0u;
#pragma unroll
        for (unsigned j = 0; j < 16; ++j) { const unsigned c = xb_ld(&bar[XB_XCNT(j)]); sum += c; cnt += (c > 0u) ? 1u : 0u; mine = (j == x) ? c : mine; }
        if (sum == G) break;
        __builtin_amdgcn_s_sleep(1);
        if ((++sp & 255u) == 0u) { if (xb_ld(&bar[XB_TMO])) break; if (sp > XB_SPIN_CAP) { atomicAdd(&bar[XB_TMO], 1u); break; } }
    }
    nloc = mine > 0u ? mine : 1u; nx = cnt > 0u ? cnt : 1u;
}

__device__ __forceinline__ void xcd_barrier(const XcdBarrier& b, bool leader) {
    asm volatile("s_waitcnt vmcnt(0)" ::: "memory");
    __syncthreads();
    if (leader) {
        unsigned* bar = b.bar;
        __builtin_amdgcn_s_waitcnt(0);
        unsigned nloc = b.st[0], nx = b.st[1];
        if (nloc == 0u) { xcd_barrier_complete(bar, b.x, nloc, nx); b.st[0] = nloc; b.st[1] = nx; }
        const unsigned old = xb_add(&bar[XB_XSUB(b.x)], 1u);
        const unsigned gen = old / nloc;
        if (old + 1u == (gen + 1u) * nloc) {
            __builtin_amdgcn_fence(__ATOMIC_RELEASE, "agent");
            asm volatile("s_waitcnt vmcnt(0)" ::: "memory");
            const unsigned og = xb_add(&bar[XB_TOP], 1u);
            const unsigned tg = og / nx;
            if (og + 1u == (tg + 1u) * nx) xb_add(&bar[XB_TOPGEN], 1u);
            else XB_SPIN(xb_ld(&bar[XB_TOPGEN]) == tg, bar);
            __builtin_amdgcn_fence(__ATOMIC_ACQUIRE, "agent");
            xb_add(&bar[XB_XGEN(b.x)], 1u);
            asm volatile("s_waitcnt vmcnt(0)" ::: "memory");
        } else {
            XB_SPIN(xb_ld(&bar[XB_XGEN(b.x)]) == gen, bar);
            __builtin_amdgcn_fence(__ATOMIC_ACQUIRE, "agent");
            asm volatile("s_waitcnt vmcnt(0)" ::: "memory");
        }
    }
    __syncthreads();
}

__device__ __forceinline__ void grid_barrier(unsigned* ctr, unsigned epoch, unsigned nblocks) {
    asm volatile("s_waitcnt vmcnt(0)" ::: "memory");
    __syncthreads();
    if (threadIdx.x == 0) {
        __builtin_amdgcn_fence(__ATOMIC_RELEASE, "agent");
        asm volatile("s_waitcnt vmcnt(0)" ::: "memory");
        __hip_atomic_fetch_add(ctr, 1u, __ATOMIC_RELAXED, __HIP_MEMORY_SCOPE_AGENT);
        const unsigned want = epoch * nblocks;
        while (__hip_atomic_load(ctr, __ATOMIC_RELAXED, __HIP_MEMORY_SCOPE_AGENT) < want) __builtin_amdgcn_s_sleep(2);
        __builtin_amdgcn_fence(__ATOMIC_ACQUIRE, "agent");
        asm volatile("s_waitcnt vmcnt(0)" ::: "memory");
    }
    __syncthreads();
}
__global__ void __launch_bounds__(NTHREADS) mk_fwd(Params p, int ph_lo, int ph_hi, int use_sync) {
    extern __shared__ __attribute__((aligned(16))) char lds[];
    const int wid_s = __builtin_amdgcn_readfirstlane((int)__builtin_amdgcn_workitem_id_x() >> 6);
#ifndef MK_HYBRID
    cg::this_grid().sync();
#endif
    volatile LAS unsigned* xb_st = (volatile LAS unsigned*)((LAS char*)lds + LDS_BYTES - 16);
    if (threadIdx.x < 4) xb_st[threadIdx.x] = 0u;
    __syncthreads();
    const XcdBarrier xb = xcd_barrier_post(PF(bar), xb_st, threadIdx.x == 0);
    for (int ph = ph_lo; ph < ph_hi; ++ph) {
        run_phase<-1>(p, ph, lds, wid_s);
#ifdef REPMASK
        if ((REPMASK >> (PPROG(ph) & 0xff)) & 1) { xcd_barrier(xb, wid_s == 0 && fresh_lane() == 0); run_phase<-1>(p, ph, lds, wid_s); }
#endif
        if ((PPROG(ph) >> 25) & 1) __syncthreads();
        else if (use_sync && ph + 1 < ph_hi) xcd_barrier(xb, wid_s == 0 && fresh_lane() == 0);
    }
}
#endif
#ifdef MK_HYBRID
template <int KIND>
__global__ void __launch_bounds__(NTHREADS) mk_one(Params p, int ph) {
    extern __shared__ __attribute__((aligned(16))) char lds[];
    run_phase<KIND>(p, ph, lds, __builtin_amdgcn_readfirstlane((int)__builtin_amdgcn_workitem_id_x() >> 6));
}
typedef void (*phase_kernel_t)(Params, int);
static phase_kernel_t phase_kernel(int kind) {
    switch (kind) {
    case PH_MOD: return mk_one<PH_MOD>; case PH_PREP: return mk_one<PH_PREP>; case PH_AB_INPROJ: return mk_one<PH_AB_INPROJ>; case PH_AB_QKNORM: return mk_one<PH_AB_QKNORM>;
    case PH_A_ATTN: return mk_one<PH_A_ATTN>; case PH_B_ATTN: return mk_one<PH_B_ATTN>; case PH_OUTPROJ: return mk_one<PH_OUTPROJ>; case PH_C_INPROJ: return mk_one<PH_C_INPROJ>;
    case PH_C_PRE: return mk_one<PH_C_PRE>; case PH_C_SCAN: return mk_one<PH_C_SCAN>; case PH_C_ZOG: return mk_one<PH_C_ZOG>; default: return mk_one<PH_C_FINISH>;
    }
}
#endif

static size_t align_up(size_t v, size_t a) { return (v + a - 1) / a * a; }

extern "C" void kernel_launch(void* const* d_in, const int* in_sizes, int n_in, void* d_out, int out_size, void* d_ws, size_t ws_size, hipStream_t stream) {
    static int grid = 0;
    Params p{};
    if (n_in != 29) { fprintf(stderr, "kernel_launch: expected 29 inputs, got %d\n", n_in); return; }
    const float** ip = (const float**)&p.x;
    for (int i = 0; i < 29; ++i) ip[i] = (const float*)d_in[i];
    p.out = (float*)d_out; p.bar = (unsigned*)d_ws;
    char* ws = (char*)d_ws; size_t off = 16384;
    p.mod = (float*)(ws + off); off = align_up(off + (size_t)4 * 9 * 3072 * 4, 256);
    p.hctx = (float*)(ws + off); off = align_up(off + (size_t)NBATCH * CTXL * DM * 4, 256);
    p.win = (bf16_t*)(ws + off); off = align_up(off + (size_t)4 * EI * DM * 2, 256);
    p.win2 = (bf16_t*)(ws + off); off = align_up(off + (size_t)4 * EI * DM * 2, 256);
    p.wout = (bf16_t*)(ws + off); off = align_up(off + (size_t)DM * EI * 2, 256);
    p.u = (bf16_t*)(ws + off); off = align_up(off + (size_t)NTOK * DM * 2, 256);
    for (int i = 0; i < 5; ++i) { p.buf[i] = (bf16_t*)(ws + off); off = align_up(off + BUFE * 2, 256); }
    p.sbuf = (float*)(ws + off); off = align_up(off + (size_t)GB * 4 * NCHUNK * 4096 * 4, 256);
    p.gates = (float*)(ws + off); off = align_up(off + (size_t)GT * 64 * 4, 256);
    p.gwt = (bf16_t*)(ws + off); off = align_up(off + (size_t)16 * 6144 * 2, 256);
    if (off > ws_size) { fprintf(stderr, "kernel_launch: workspace too small: need %zu have %zu\n", off, ws_size); return; }
    int n = 0;
    auto add = [&](int kind, int layer, int g) { p.prog[n++] = kind | (layer << 8) | (g << 16); };
    const int NB = 1 << 25, MG = 1 << 24, LO64 = 1 << 26, LO160 = 2 << 26, LO176 = 3 << 26;
    add(PH_MOD, 0, 0);
    add(PH_NORM, 0, 0);
    add(PH_AB_INPROJ, 0, 0);
    add(PH_A_ATTN | NB, 0, 0); add(PH_NORM, 0, 1);
    add(PH_OUTPROJ | NB, 0, 0); add(PH_AB_INPROJ | MG | NB, 0, 1); add(PH_WCONV | LO160, 1, 0);
    add(PH_A_ATTN | NB, 0, 1); add(PH_NORM, 1, 0);
    add(PH_OUTPROJ | NB, 0, 1); add(PH_AB_INPROJ | MG, 1, 0);
    add(PH_B_ATTN | NB, 1, 0); add(PH_NORM | NB, 1, 1); add(PH_WCONV, 1, 1);
    add(PH_OUTPROJ | NB, 1, 0); add(PH_AB_INPROJ | MG | NB, 1, 1); add(PH_WCONV | LO160, 2, 0);
    add(PH_B_ATTN | NB, 1, 1); add(PH_NORM, 2, 0);
    add(PH_OUTPROJ | NB, 1, 1); add(PH_C_INPROJ | MG | NB, 2, 0); add(PH_WCONV | LO176, 3, 0);
    add(PH_C_PRE, 2, 0); add(PH_C_SCAN, 2, 0);
    add(PH_C_ZOG | NB, 2, 0); add(PH_NORM | LO64 | NB, 2, 1); add(PH_WCONV | LO64, 2, 1);
    add(PH_C_FINISH, 2, 0);
    add(PH_OUTPROJ | NB, 2, 0); add(PH_C_INPROJ | MG, 2, 1);
    add(PH_C_PRE, 2, 1); add(PH_C_SCAN, 2, 1);
    add(PH_C_ZOG | NB, 2, 1); add(PH_NORM | LO64, 3, 0);
    add(PH_C_FINISH, 2, 1);
    add(PH_OUTPROJ | NB, 2, 1); add(PH_AB_INPROJ | MG, 3, 0);
    add(PH_A_ATTN | NB, 3, 0); add(PH_NORM | NB, 3, 1); add(PH_WCONV, 3, 1);
    add(PH_OUTPROJ | NB, 3, 0); add(PH_AB_INPROJ | MG, 3, 1);
    add(PH_A_ATTN, 3, 1);
    add(PH_OUTPROJ, 3, 1);
    p.nphases = n;
#ifdef MK_HYBRID
    if (grid == 0) {
        for (int k = 0; k <= PH_C_FINISH; ++k)
            if (hipFuncSetAttribute((const void*)phase_kernel(k), hipFuncAttributeMaxDynamicSharedMemorySize, LDS_BYTES) != hipSuccess) { grid = -1; return; }
        if (hipFuncSetAttribute((const void*)mk_fwd, hipFuncAttributeMaxDynamicSharedMemorySize, LDS_BYTES) != hipSuccess) { grid = -1; return; }
        grid = 256;
    }
    if (grid < 0) return;
    for (int ph = 0; ph < p.nphases; ++ph) {
        const int kind = p.prog[ph] & 0xff;
        if ((MK_HYBRID >> kind) & 1) hipLaunchKernelGGL(mk_fwd, dim3(grid), dim3(NTHREADS), LDS_BYTES, stream, p, ph, ph + 1, 0);
        else hipLaunchKernelGGL(phase_kernel(kind), dim3(grid), dim3(NTHREADS), LDS_BYTES, stream, p, ph);
    }
#else
    if (grid == 0) {
        if (hipFuncSetAttribute((const void*)mk_fwd, hipFuncAttributeMaxDynamicSharedMemorySize, LDS_BYTES) != hipSuccess) { fprintf(stderr, "kernel_launch: hipFuncSetAttribute failed\n"); grid = -1; return; }
        int dev = 0, cus = 0, per_cu = 0;
        if (hipGetDevice(&dev) != hipSuccess || hipDeviceGetAttribute(&cus, hipDeviceAttributeMultiprocessorCount, dev) != hipSuccess || cus <= 0) { fprintf(stderr, "kernel_launch: device query failed\n"); grid = -1; return; }
        if (hipOccupancyMaxActiveBlocksPerMultiprocessor(&per_cu, (const void*)mk_fwd, NTHREADS, LDS_BYTES) != hipSuccess || per_cu < 1) { fprintf(stderr, "kernel_launch: occupancy query failed (%d)\n", per_cu); grid = -1; return; }
        grid = cus;
    }
    if (grid < 0) return;
    if (hipMemsetAsync(d_ws, 0, 16384, stream) != hipSuccess) { fprintf(stderr, "kernel_launch: memset failed\n"); return; }
    int ph_lo = 0, ph_hi = p.nphases, use_sync = 1;
    void* args[] = {&p, &ph_lo, &ph_hi, &use_sync};
    const hipError_t e = hipLaunchCooperativeKernel((const void*)mk_fwd, dim3(grid), dim3(NTHREADS), args, LDS_BYTES, stream);
    if (e != hipSuccess) fprintf(stderr, "kernel_launch: cooperative launch failed: %s (grid %d)\n", hipGetErrorString(e), grid);
#endif
}
```
